# Optimizing an MI355X kernel written in HIP

```python
import math
import jax, jax.numpy as jnp
from jax import lax
import numpy as np

D_MODEL = 1024
BATCH = 4
SEQ = 4096
DEPTH = 2

N_MEM = 256
D_MIX = D_MODEL
NSA_HEADS = 8
NSA_KV_HEADS = 2
NSA_GROUP = NSA_HEADS // NSA_KV_HEADS
HEAD_DIM = 64
D_NSA = NSA_HEADS * HEAD_DIM
D_KV = NSA_KV_HEADS * HEAD_DIM
ROT_DIM = HEAD_DIM // 4
ROPE_THETA = 500000.0
CMP_BLOCK = 32
CMP_STRIDE = 16
CMP_HIDDEN = 256
SEL_BLOCK = 64
SEL_TOPN = 16
WINDOW = 512
Q_BLOCK = 128
D_CONV = D_MIX // 4
CONV_WIDTH = 31
D_POOL = D_MIX // 4
POOL_WINDOWS = (2, 4, 8, 16)
POOL_GROUP = D_POOL // len(POOL_WINDOWS)
IN_SPLITS = (D_NSA,) + (D_KV,) * 6 + (3 * NSA_HEADS, D_CONV, D_CONV, D_POOL)
IN_OFFSETS = tuple(int(v) for v in np.cumsum(IN_SPLITS)[:-1])
D_IN = sum(IN_SPLITS)
XA_HEADS = 4
XA_HEAD_DIM = D_MODEL // XA_HEADS
PEER_HEADS = 8
PEER_KEYS = 128
PEER_EXPERTS = PEER_KEYS ** 2
PEER_QDIM = 256
PEER_HALF = PEER_QDIM // 2
PEER_TOPK = 16
TOKEN_CHUNK = 128
EPS = 1e-6
NEG = -1e30
FORCE = 1e4

kernel_name = 'hymba_style_nsa_conv_pool_peer_block'


def _rmsnorm(x, g):
    xf = x.astype(jnp.float32)
    y = xf * lax.rsqrt(jnp.mean(xf * xf, axis=-1, keepdims=True) + EPS)
    return (y * g.astype(jnp.float32)).astype(x.dtype)


def _layernorm(x, g, b):
    xf = x.astype(jnp.float32)
    mu = jnp.mean(xf, axis=-1, keepdims=True)
    xc = xf - mu
    y = xc * lax.rsqrt(jnp.mean(xc * xc, axis=-1, keepdims=True) + EPS)
    return (y * g.astype(jnp.float32) + b.astype(jnp.float32)).astype(x.dtype)


def _rope(x, pos):
    half = ROT_DIM // 2
    freqs = ROPE_THETA ** (-jnp.arange(half, dtype=jnp.float32) * 2.0 / ROT_DIM)
    ang = pos.astype(jnp.float32)[:, :, None, None] * freqs
    cos, sin = jnp.cos(ang), jnp.sin(ang)
    xf = x.astype(jnp.float32)
    x1, x2, rest = xf[..., :half], xf[..., half:ROT_DIM], xf[..., ROT_DIM:]
    out = jnp.concatenate([x1 * cos - x2 * sin, x1 * sin + x2 * cos, rest], axis=-1)
    return out.astype(x.dtype)


def _nsa(q, kc, vc, ks, vs, kw, vw, gates, pos, cmp_pe, cmp_w1, cmp_w2):
    B, S = q.shape[0], q.shape[1]
    scale = HEAD_DIM ** -0.5
    q, kc, ks, kw = _rope(q, pos), _rope(kc, pos), _rope(ks, pos), _rope(kw, pos)
    qg = q.reshape(B, S, NSA_KV_HEADS, NSA_GROUP, HEAD_DIM)
    tpos_all = jnp.arange(S)

    n_cmp = (S - CMP_BLOCK) // CMP_STRIDE + 1
    cidx = jnp.arange(n_cmp)[:, None] * CMP_STRIDE + jnp.arange(CMP_BLOCK)[None, :]

    def compress(t, pe, w1, w2):
        blk = t[:, cidx] + pe[None, None, :, None, :]
        blk = jnp.moveaxis(blk, 3, 2).reshape(B, n_cmp, NSA_KV_HEADS, CMP_BLOCK * HEAD_DIM)
        return jax.nn.gelu(blk @ w1) @ w2

    k_cmp = compress(kc, cmp_pe[0], cmp_w1[0], cmp_w2[0])
    v_cmp = compress(vc, cmp_pe[1], cmp_w1[1], cmp_w2[1])
    s_cmp = jnp.einsum('bskgd,bnkd->bkgsn', qg, k_cmp).astype(jnp.float32) * scale
    cmp_end = jnp.arange(n_cmp) * CMP_STRIDE + CMP_BLOCK - 1
    valid_cmp = cmp_end[None, :] <= tpos_all[:, None]
    p_cmp = jnp.where(valid_cmp, jax.nn.softmax(jnp.where(valid_cmp, s_cmp, NEG), axis=-1), 0.0)
    o_cmp = jnp.einsum('bkgsn,bnkd->bskgd', p_cmp.astype(v_cmp.dtype), v_cmp)

    n_sel = S // SEL_BLOCK
    n_top = min(SEL_TOPN, n_sel)
    ci = jnp.arange(n_cmp) * CMP_STRIDE
    sj = jnp.arange(n_sel) * SEL_BLOCK
    overlap = ((ci[:, None] < sj[None, :] + SEL_BLOCK) & (ci[:, None] + CMP_BLOCK > sj[None, :])).astype(jnp.float32)
    imp = jnp.einsum('bkgsn,nj->bksj', p_cmp, overlap)
    blk_id = jnp.arange(n_sel)[None, :]
    cur = (tpos_all // SEL_BLOCK)[:, None]
    forced = (blk_id == 0) | (blk_id == cur) | (blk_id == cur - 1)
    causal_blk = blk_id * SEL_BLOCK <= tpos_all[:, None]
    imp = jnp.where(causal_blk, jnp.where(forced, FORCE, imp), NEG)
    _, sel_idx = lax.top_k(imp, n_top)

    ks_blocks = jnp.transpose(ks.reshape(B, n_sel, SEL_BLOCK, NSA_KV_HEADS, HEAD_DIM), (0, 3, 1, 2, 4))
    vs_blocks = jnp.transpose(vs.reshape(B, n_sel, SEL_BLOCK, NSA_KV_HEADS, HEAD_DIM), (0, 3, 1, 2, 4))
    gather = jax.vmap(jax.vmap(lambda kb, ix: kb[ix]))
    kw_pad = jnp.pad(kw, ((0, 0), (WINDOW, 0), (0, 0), (0, 0)))
    vw_pad = jnp.pad(vw, ((0, 0), (WINDOW, 0), (0, 0), (0, 0)))

    def q_block(qb):
        t0 = qb * Q_BLOCK
        tpos = t0 + jnp.arange(Q_BLOCK)
        qblk = lax.dynamic_slice_in_dim(qg, t0, Q_BLOCK, axis=1)
        sidx = lax.dynamic_slice_in_dim(sel_idx, t0, Q_BLOCK, axis=2)
        kg = gather(ks_blocks, sidx)
        vg = gather(vs_blocks, sidx).reshape(B, NSA_KV_HEADS, Q_BLOCK, n_top * SEL_BLOCK, HEAD_DIM)
        kpos = sidx[..., None] * SEL_BLOCK + jnp.arange(SEL_BLOCK)
        msel = (kpos <= tpos[None, None, :, None, None]).reshape(B, NSA_KV_HEADS, 1, Q_BLOCK, n_top * SEL_BLOCK)
        s = jnp.einsum('btkgd,bktnld->bkgtnl', qblk, kg).astype(jnp.float32) * scale
        s = s.reshape(B, NSA_KV_HEADS, NSA_GROUP, Q_BLOCK, n_top * SEL_BLOCK)
        p = jax.nn.softmax(jnp.where(msel, s, NEG), axis=-1).astype(vg.dtype)
        o_sel = jnp.einsum('bkgtm,bktmd->btkgd', p, vg)
        kwb = lax.dynamic_slice_in_dim(kw_pad, t0, WINDOW + Q_BLOCK, axis=1)
        vwb = lax.dynamic_slice_in_dim(vw_pad, t0, WINDOW + Q_BLOCK, axis=1)
        kp = t0 - WINDOW + jnp.arange(WINDOW + Q_BLOCK)
        mw = (kp[None, :] >= 0) & (kp[None, :] <= tpos[:, None]) & (kp[None, :] > tpos[:, None] - WINDOW)
        sw = jnp.einsum('btkgd,bmkd->bkgtm', qblk, kwb).astype(jnp.float32) * scale
        pw = jax.nn.softmax(jnp.where(mw, sw, NEG), axis=-1).astype(vwb.dtype)
        o_win = jnp.einsum('bkgtm,bmkd->btkgd', pw, vwb)
        return o_sel, o_win

    o_sel, o_win = lax.map(q_block, jnp.arange(S // Q_BLOCK))
    o_sel = jnp.swapaxes(o_sel, 0, 1).reshape(B, S, NSA_KV_HEADS, NSA_GROUP, HEAD_DIM)
    o_win = jnp.swapaxes(o_win, 0, 1).reshape(B, S, NSA_KV_HEADS, NSA_GROUP, HEAD_DIM)
    g = jax.nn.sigmoid(gates.reshape(B, S, NSA_KV_HEADS, NSA_GROUP, 3))
    o = g[..., 0:1] * o_cmp + g[..., 1:2] * o_sel + g[..., 2:3] * o_win
    return o.reshape(B, S, D_NSA)


def _conformer_conv(a, b, conv_w, conv_b, ln_g, ln_b, pw_w, pw_b):
    h = a * jax.nn.sigmoid(b)
    h = jnp.pad(h, ((0, 0), (CONV_WIDTH - 1, 0), (0, 0)))
    h = lax.conv_general_dilated(h, conv_w[:, None, :].astype(h.dtype), window_strides=(1,), padding='VALID',
                                 dimension_numbers=('NWC', 'WIO', 'NWC'), feature_group_count=D_CONV) + conv_b
    h = jax.nn.silu(_layernorm(h, ln_g, ln_b))
    return h @ pw_w + pw_b


def _pool_mixer(h, pool_w, pool_scale):
    B, S = h.shape[0], h.shape[1]
    hf = h.astype(jnp.float32)
    c = jnp.concatenate([jnp.zeros((B, 1, D_POOL), jnp.float32), jnp.cumsum(hf, axis=1)], axis=1)
    t = jnp.arange(S)
    outs = []
    for gi, w in enumerate(POOL_WINDOWS):
        lo, hi = gi * POOL_GROUP, (gi + 1) * POOL_GROUP
        start = jnp.maximum(t + 1 - w, 0)
        cnt = (t + 1 - start).astype(jnp.float32)
        mean = (c[:, t + 1, lo:hi] - c[:, start, lo:hi]) / cnt[None, :, None]
        outs.append(mean - hf[:, :, lo:hi])
    m = jnp.stack(outs, axis=2).astype(h.dtype)
    y = jnp.einsum('bsgc,gcd->bsgd', m, pool_w).reshape(B, S, D_POOL)
    return y * pool_scale


def _cross_attention(h, memn, wq, wkv, wo):
    B, S = h.shape[0], h.shape[1]
    q = (h @ wq).reshape(B, S, XA_HEADS, XA_HEAD_DIM)
    kv = (memn @ wkv).reshape(B, memn.shape[1], 2, XA_HEADS, XA_HEAD_DIM)
    k, v = kv[:, :, 0], kv[:, :, 1]
    s = jnp.einsum('bshd,bmhd->bhsm', q, k).astype(jnp.float32) * (XA_HEAD_DIM ** -0.5)
    p = jax.nn.softmax(s, axis=-1).astype(v.dtype)
    o = jnp.einsum('bhsm,bmhd->bshd', p, v).reshape(B, S, D_MODEL)
    return o @ wo


def _peer(h, wq, sub_keys, u, v):
    B, S, D = h.shape
    T = B * S
    hf = h.reshape(T, D)
    q = (hf @ wq).reshape(T, PEER_HEADS, 2, PEER_HALF)
    s_half = jnp.einsum('thpc,pnc->thpn', q, sub_keys).astype(jnp.float32)
    v_half, i_half = lax.top_k(s_half, PEER_TOPK)
    cand = (v_half[:, :, 0, :, None] + v_half[:, :, 1, None, :]).reshape(T, PEER_HEADS, PEER_TOPK * PEER_TOPK)
    cand_idx = (i_half[:, :, 0, :, None] * PEER_KEYS + i_half[:, :, 1, None, :]).reshape(T, PEER_HEADS, PEER_TOPK * PEER_TOPK)
    top_s, top_pos = lax.top_k(cand, PEER_TOPK)
    expert_idx = jnp.take_along_axis(cand_idx, top_pos, axis=-1)
    gate = jax.nn.softmax(top_s, axis=-1).astype(h.dtype)
    n_chunks = T // TOKEN_CHUNK

    def chunk(args):
        hc, ic, gc = args
        act = jax.nn.gelu(jnp.einsum('cd,chkd->chk', hc, u[ic]))
        return jnp.einsum('chk,chkd->cd', gc * act, v[ic])

    out = lax.map(chunk, (hf.reshape(n_chunks, TOKEN_CHUNK, D),
                          expert_idx.reshape(n_chunks, TOKEN_CHUNK, PEER_HEADS, PEER_TOPK),
                          gate.reshape(n_chunks, TOKEN_CHUNK, PEER_HEADS, PEER_TOPK)))
    return out.reshape(B, S, D)


def setup_inputs(seed: int = 0) -> dict:
    key = jax.random.key(seed)
    ks = jax.random.split(key, 32)
    f32 = jnp.float32

    def nrm(k, shape, scale):
        return jax.random.normal(k, shape, f32) * scale

    def gain(k, shape):
        return 1.0 + 0.01 * jax.random.normal(k, shape, f32)

    L = DEPTH
    return {
        'x': nrm(ks[0], (BATCH, SEQ, D_MODEL), 1.0),
        'mem': nrm(ks[1], (BATCH, N_MEM, D_MODEL), 1.0),
        'positions': jax.random.randint(ks[2], (BATCH, 1), 0, 1024, jnp.int32) + jnp.arange(SEQ, dtype=jnp.int32)[None, :],
        'norm_mix_g': gain(ks[3], (L, D_MODEL)),
        'w_in': nrm(ks[4], (L, D_MODEL, D_IN), D_MODEL ** -0.5),
        'cmp_pe': nrm(ks[5], (L, 2, CMP_BLOCK, HEAD_DIM), 0.1),
        'cmp_w1': nrm(ks[6], (L, 2, CMP_BLOCK * HEAD_DIM, CMP_HIDDEN), (CMP_BLOCK * HEAD_DIM) ** -0.5),
        'cmp_w2': nrm(ks[7], (L, 2, CMP_HIDDEN, HEAD_DIM), CMP_HIDDEN ** -0.5),
        'conv_w': nrm(ks[8], (L, CONV_WIDTH, D_CONV), CONV_WIDTH ** -0.5),
        'conv_b': nrm(ks[9], (L, D_CONV), 0.01),
        'conv_ln_g': gain(ks[10], (L, D_CONV)),
        'conv_ln_b': nrm(ks[11], (L, D_CONV), 0.01),
        'conv_pw_w': nrm(ks[12], (L, D_CONV, D_CONV), D_CONV ** -0.5),
        'conv_pw_b': nrm(ks[13], (L, D_CONV), 0.01),
        'pool_w': nrm(ks[14], (L, len(POOL_WINDOWS), POOL_GROUP, POOL_GROUP), POOL_GROUP ** -0.5),
        'pool_scale': gain(ks[15], (L, D_POOL)),
        'w_out': nrm(ks[16], (L, D_MIX, D_MODEL), D_MIX ** -0.5),
        'norm_xa_g': gain(ks[17], (L, D_MODEL)),
        'norm_mem_g': gain(ks[18], (L, D_MODEL)),
        'xa_wq': nrm(ks[19], (L, D_MODEL, D_MODEL), D_MODEL ** -0.5),
        'xa_wkv': nrm(ks[20], (L, D_MODEL, 2 * D_MODEL), D_MODEL ** -0.5),
        'xa_wo': nrm(ks[21], (L, D_MODEL, D_MODEL), D_MODEL ** -0.5),
        'norm_ffn_g': gain(ks[22], (L, D_MODEL)),
        'peer_wq': nrm(ks[23], (L, D_MODEL, PEER_HEADS * PEER_QDIM), D_MODEL ** -0.5),
        'peer_subkeys': nrm(ks[24], (L, 2, PEER_KEYS, PEER_HALF), PEER_HALF ** -0.5),
        'peer_u': nrm(ks[25], (L, PEER_EXPERTS, D_MODEL), D_MODEL ** -0.5),
        'peer_v': nrm(ks[26], (L, PEER_EXPERTS, D_MODEL), PEER_HEADS ** -0.5),
        'final_g': gain(ks[27], (D_MODEL,)),
    }


def reference(x, mem, positions, norm_mix_g, w_in, cmp_pe, cmp_w1, cmp_w2, conv_w, conv_b, conv_ln_g, conv_ln_b,
              conv_pw_w, conv_pw_b, pool_w, pool_scale, w_out, norm_xa_g, norm_mem_g, xa_wq, xa_wkv, xa_wo,
              norm_ffn_g, peer_wq, peer_subkeys, peer_u, peer_v, final_g):
    B, S = x.shape[0], x.shape[1]
    for l in range(DEPTH):
        h = _rmsnorm(x, norm_mix_g[l])
        z = h @ w_in[l]
        (zq, zkc, zvc, zks, zvs, zkw, zvw, zg, za, zb, zp) = jnp.split(z, IN_OFFSETS, axis=-1)
        kv = lambda t: t.reshape(B, S, NSA_KV_HEADS, HEAD_DIM)
        o_nsa = _nsa(zq.reshape(B, S, NSA_HEADS, HEAD_DIM), kv(zkc), kv(zvc), kv(zks), kv(zvs), kv(zkw), kv(zvw),
                     zg, positions, cmp_pe[l], cmp_w1[l], cmp_w2[l])
        o_conv = _conformer_conv(za, zb, conv_w[l], conv_b[l], conv_ln_g[l], conv_ln_b[l], conv_pw_w[l], conv_pw_b[l])
        o_pool = _pool_mixer(zp, pool_w[l], pool_scale[l])
        x = x + jnp.concatenate([o_nsa, o_conv, o_pool], axis=-1) @ w_out[l]
        x = x + _cross_attention(_rmsnorm(x, norm_xa_g[l]), _rmsnorm(mem, norm_mem_g[l]), xa_wq[l], xa_wkv[l], xa_wo[l])
        x = x + _peer(_rmsnorm(x, norm_ffn_g[l]), peer_wq[l], peer_subkeys[l], peer_u[l], peer_v[l])
    return _rmsnorm(x, final_g)
```

```cpp
#include <hip/hip_runtime.h>
#include <hip/hip_cooperative_groups.h>
#include <cstdio>
#include <cstdint>
#include <cmath>
namespace cg = cooperative_groups;

#ifndef SINGLE_LAUNCH
#define SINGLE_LAUNCH 1
#endif

typedef unsigned short bf16_t;
typedef short bf16x8 __attribute__((ext_vector_type(8)));
typedef float f32x4 __attribute__((ext_vector_type(4)));
typedef __bf16 bf16x2_t __attribute__((ext_vector_type(2)));

constexpr int NB = 4, S_ = 4096, T_ = NB * S_, DM = 1024;
constexpr int NWIN = 2176;
constexpr int NCMP = 255;
constexpr float EPS = 1e-6f;
constexpr float NEGF = -1e30f;
constexpr int LDS_PHASE_BYTES = 72 * 1024;
constexpr int LDS_BYTES = LDS_PHASE_BYTES + 64;
constexpr int NTHREADS = 256;

constexpr size_t MB = 1024 * 1024;
constexpr size_t WS_CTL    = 0;
constexpr size_t WS_KNMAX  = 32 * 1024;
constexpr size_t WS_CBPART = 1 * MB;
constexpr size_t WS_SUMSQ  = 2 * MB;
constexpr size_t WS_PARTS0 = WS_SUMSQ + 4 * T_ * 16 * 4;
constexpr size_t WS_RSTDM  = WS_PARTS0 + (size_t)T_ * 16 * 4;
constexpr size_t WS_ROPE   = WS_RSTDM + 4096;
constexpr size_t WS_GATES  = WS_ROPE + (size_t)T_ * 16 * 4;
constexpr size_t WS_MEMB   = WS_GATES + (size_t)T_ * 24 * 4;
constexpr size_t WS_KMEM   = WS_MEMB + 2 * MB;
constexpr size_t WS_VMEMT  = WS_KMEM + 4 * MB;
constexpr size_t WS_KCMP   = WS_VMEMT + 4 * MB;
constexpr size_t WS_VCMPT  = WS_KCMP + 256 * 1024;
constexpr size_t WS_HID    = WS_VCMPT + 256 * 1024;
constexpr size_t WS_W      = WS_HID + 2 * MB;
constexpr size_t W_WIN   = 0;
constexpr size_t W_WOUT  = W_WIN + (size_t)NWIN * 1024 * 2;
constexpr size_t W_XWQ   = W_WOUT + 2 * MB;
constexpr size_t W_XWKV  = W_XWQ + 2 * MB;
constexpr size_t W_XWO   = W_XWKV + 4 * MB;
constexpr size_t W_PWQ   = W_XWO + 2 * MB;
constexpr size_t W_CW1   = W_PWQ + 4 * MB;
constexpr size_t W_CW2   = W_CW1 + 2 * MB;
constexpr size_t W_CBIAS = W_CW2 + 64 * 1024;
constexpr size_t W_PW    = W_CBIAS + 4096;
constexpr size_t W_POOLW = W_PW + 128 * 1024;
constexpr size_t W_SUBK  = W_POOLW + 32 * 1024;
constexpr size_t W_STRIDE = W_SUBK + 64 * 1024;
constexpr size_t WS_UB     = WS_W + 2 * W_STRIDE;
constexpr size_t WS_VB     = WS_UB + 64 * MB;
constexpr size_t WS_XRES   = WS_VB + 64 * MB;
constexpr size_t WS_XB     = WS_XRES + 64 * MB;
constexpr size_t WS_NSA    = WS_XB + 32 * MB;
constexpr size_t WS_Q      = WS_NSA;
constexpr size_t WS_KC     = WS_Q + 16 * MB;
constexpr size_t WS_KS     = WS_KC + 4 * MB;
constexpr size_t WS_KW     = WS_KS + 4 * MB;
constexpr size_t WS_VC     = WS_KW + 4 * MB;
constexpr size_t WS_VST    = WS_VC + 4 * MB;
constexpr size_t WS_VWT    = WS_VST + 4 * MB;
constexpr size_t WS_GLU    = WS_VWT + 4 * MB;
constexpr size_t WS_ZP     = WS_GLU + 8 * MB;
constexpr size_t WS_PQ     = WS_NSA;
constexpr size_t WS_MIX    = WS_NSA + 64 * MB;
constexpr size_t WS_QXA    = WS_MIX + 32 * MB;
constexpr size_t WS_TOPK   = WS_QXA + 32 * MB;
constexpr size_t WS_CPART  = WS_TOPK;
constexpr size_t WS_EID    = WS_TOPK + 16 * MB;
constexpr size_t WS_GATE   = WS_EID + 4 * MB;
constexpr size_t WS_ACT    = WS_GATE + 8 * MB;
constexpr size_t WS_HN     = WS_QXA;
constexpr size_t WS_END    = WS_ACT + 8 * MB;

struct Params {
    const float* in[28];
    float* out;
    char* ws;
    double freq[8];
    int ph_lo, ph_hi;
};

__device__ __forceinline__ float bf2f(bf16_t b) { return __uint_as_float(((unsigned)b) << 16); }
typedef float f32x2_t __attribute__((ext_vector_type(2)));
__device__ __forceinline__ bf16_t f2bf(float f) { __bf16 h = (__bf16)f; return __builtin_bit_cast(bf16_t, h); }
__device__ __forceinline__ unsigned pack2(float a, float b) { f32x2_t v = {a, b}; bf16x2_t h = __builtin_convertvector(v, bf16x2_t); return __builtin_bit_cast(unsigned, h); }
template <int CTRL> __device__ __forceinline__ float dppf(float v) { return __builtin_bit_cast(float, __builtin_amdgcn_update_dpp(0, __builtin_bit_cast(int, v), CTRL, 0xf, 0xf, false)); }
__device__ __forceinline__ float row16_sum(float v) { v += dppf<0xB1>(v); v += dppf<0x4E>(v); v += dppf<0x141>(v); v += dppf<0x140>(v); return v; }
__device__ __forceinline__ float row16_max(float v) { v = fmaxf(v, dppf<0xB1>(v)); v = fmaxf(v, dppf<0x4E>(v)); v = fmaxf(v, dppf<0x141>(v)); v = fmaxf(v, dppf<0x140>(v)); return v; }
__device__ __forceinline__ float sigmoidf_(float x) { return 1.f / (1.f + __expf(-x)); }
__device__ __forceinline__ float gelu_tanh(float x) {
    const float y = 0.7978845608028654f * (x + 0.044715f * x * x * x);
    const float e = __expf(2.f * y);
    const float t = 1.f - 2.f / (e + 1.f);
    return 0.5f * x * (1.f + t);
}
__device__ __forceinline__ float wave_sum(float v) {
#pragma unroll
    for (int o = 32; o >= 1; o >>= 1) v += __shfl_xor(v, o);
    return v;
}
__device__ __forceinline__ f32x4 mfma16(bf16x8 a, bf16x8 b, f32x4 c) { return __builtin_amdgcn_mfma_f32_16x16x32_bf16(a, b, c, 0, 0, 0); }
__device__ __forceinline__ float rstd_from_parts(const float* __restrict__ parts, int row) {
    const float4 a = *(const float4*)(parts + (size_t)row * 16), b = *(const float4*)(parts + (size_t)row * 16 + 4);
    const float4 c = *(const float4*)(parts + (size_t)row * 16 + 8), d = *(const float4*)(parts + (size_t)row * 16 + 12);
    const float s = ((a.x + a.y) + (a.z + a.w)) + ((b.x + b.y) + (b.z + b.w)) + ((c.x + c.y) + (c.z + c.w)) + ((d.x + d.y) + (d.z + d.w));
    return rsqrtf(s * (1.f / DM) + EPS);
}
__device__ __forceinline__ unsigned f2key(float f) { unsigned u = __float_as_uint(f); return u ^ ((unsigned)((int)u >> 31) | 0x80000000u); }
__device__ __forceinline__ float key2f(unsigned k) { k &= ~127u; unsigned u = (k & 0x80000000u) ? (k ^ 0x80000000u) : ~k; return __uint_as_float(u); }

__device__ __forceinline__ int launder(int v) { asm volatile("" : "+v"(v)); return v; }
__device__ __forceinline__ char* launder_p(char* q) { long z = 0; asm volatile("" : "+s"(z)); return q + z; }
__device__ __forceinline__ int swzr(int r) { return ((r >> 1) & 1) | ((((r >> 2) ^ (r >> 4)) & 1) << 1) | (((r >> 3) & 1) << 2); }
__device__ __forceinline__ int swz64(int row, int chunk) { return row * 64 + ((chunk ^ swzr(row)) << 3); }

struct ALin { const bf16_t* A; int lda;
    __device__ __forceinline__ const bf16_t* ptr(int row, int k) const { return A + (size_t)row * lda + k; }
    __device__ __forceinline__ const bf16_t* adv(const bf16_t* p0, int kt) const { return p0 + kt * 64; } };
struct ACmp { const bf16_t* src; int koff;
    __device__ __forceinline__ const bf16_t* ptr(int row, int k_) const {
        const int k = k_ + koff;
        const int r = row < 2040 ? row : 2039; const int kvh = r & 1, bn = r >> 1, b = bn / NCMP, n = bn - b * NCMP;
        return src + ((size_t)(b * S_ + 16 * n + (k >> 6)) * 128 + kvh * 64 + (k & 63)); }
    __device__ __forceinline__ const bf16_t* adv(const bf16_t* p0, int kt) const { return p0 + kt * 128; } };

typedef __attribute__((address_space(3))) unsigned lds_u32_t;
typedef __attribute__((address_space(1))) const unsigned glb_u32_t;
__device__ __forceinline__ void glds16(const void* gsrc, void* ldst) {
    __builtin_amdgcn_global_load_lds((glb_u32_t*)gsrc, (lds_u32_t*)ldst, 16, 0, 0);
}

template <bool SWAP, class AL, class EPI>
__device__ __forceinline__ void gemm_tile(const AL& al, const bf16_t* __restrict__ Bt, int ldb, int nB, int K, int m0, int n0, const EPI& epi, char* smem) {
    const int tid = launder(threadIdx.x), lane = tid & 63, w = __builtin_amdgcn_readfirstlane(tid >> 6), wr = w >> 1, wc = w & 1;
    bf16_t* As = (bf16_t*)smem;
    bf16_t* Bs = As + 2 * 8192;
    f32x4 acc[4][4];
#pragma unroll
    for (int i = 0; i < 4; ++i)
#pragma unroll
        for (int j = 0; j < 4; ++j) acc[i][j] = (f32x4){0.f, 0.f, 0.f, 0.f};
    const int nk = K >> 6;
    const int row_in = lane >> 3;
    const bf16_t* ga[4]; const bf16_t* gb[4];
#pragma unroll
    for (int i = 0; i < 4; ++i) {
        const int row = (w * 4 + i) * 8 + row_in;
        const int gch = ((lane & 7) ^ swzr(row)) * 8;
        ga[i] = al.ptr(m0 + row, gch);
        int br = n0 + row; br = br < nB ? br : nB - 1;
        gb[i] = Bt + (size_t)br * ldb + gch;
    }
#pragma unroll
    for (int i = 0; i < 4; ++i) {
        glds16(ga[i], As + (w * 4 + i) * 512);
        glds16(gb[i], Bs + (w * 4 + i) * 512);
    }
    asm volatile("s_waitcnt vmcnt(0)" ::: "memory");
    __syncthreads();
    for (int kt = 0; kt < nk; ++kt) {
        const int buf = kt & 1;
        if (kt + 1 < nk) {
#pragma unroll
            for (int i = 0; i < 4; ++i) {
                glds16(al.adv(ga[i], kt + 1), As + (buf ^ 1) * 8192 + (w * 4 + i) * 512);
                glds16(gb[i] + (kt + 1) * 64, Bs + (buf ^ 1) * 8192 + (w * 4 + i) * 512);
            }
        }
        const bf16_t* Ab = As + buf * 8192;
        const bf16_t* Bb = Bs + buf * 8192;
#pragma unroll
        for (int kk = 0; kk < 2; ++kk) {
            bf16x8 a[4], b[4];
            const int ch = kk * 4 + (lane >> 4);
#pragma unroll
            for (int mi = 0; mi < 4; ++mi) a[mi] = *(const bf16x8*)(Ab + swz64(wr * 64 + mi * 16 + (lane & 15), ch));
#pragma unroll
            for (int ni = 0; ni < 4; ++ni) {
                const int brow = SWAP ? ((ni >> 1) * 32 + ((lane & 15) >> 2) * 8 + (ni & 1) * 4 + (lane & 3)) : (ni * 16 + (lane & 15));
                b[ni] = *(const bf16x8*)(Bb + swz64(wc * 64 + brow, ch));
            }
#pragma unroll
            for (int mi = 0; mi < 4; ++mi)
#pragma unroll
                for (int ni = 0; ni < 4; ++ni) acc[mi][ni] = SWAP ? mfma16(b[ni], a[mi], acc[mi][ni]) : mfma16(a[mi], b[ni], acc[mi][ni]);
        }
        asm volatile("s_waitcnt vmcnt(0)" ::: "memory");
        __syncthreads();
    }
    if (SWAP) epi.swapped(acc, m0 + wr * 64, n0 + wc * 64, lane); else epi(acc, m0 + wr * 64, n0 + wc * 64, lane);
}

#define ACC8(acc, mi, p, v) float v[8] = {acc[mi][2 * (p)][0], acc[mi][2 * (p)][1], acc[mi][2 * (p)][2], acc[mi][2 * (p)][3], acc[mi][2 * (p) + 1][0], acc[mi][2 * (p) + 1][1], acc[mi][2 * (p) + 1][2], acc[mi][2 * (p) + 1][3]}
__device__ __forceinline__ uint4 pack8(const float (&v)[8]) { uint4 o; o.x = pack2(v[0], v[1]); o.y = pack2(v[2], v[3]); o.z = pack2(v[4], v[5]); o.w = pack2(v[6], v[7]); return o; }

struct EpiWin {
    const float* rstd; const float* rope; bf16_t *q, *kc, *vc, *ks, *kw, *vsT, *vwT, *glu, *zp; float* gates; unsigned* knmax;
    __device__ __forceinline__ void operator()(f32x4 (&acc)[4][4], int mb, int nb, int lane) const {
        const int lc = lane & 15, lq = lane >> 4;
        const int sec = ((nb - 512) >> 7) + 1;
        bf16_t* dst = sec == 4 ? vsT : vwT;
#pragma unroll
        for (int mi = 0; mi < 4; ++mi) {
            const int row0 = mb + mi * 16 + lq * 4;
            float rs[4];
#pragma unroll
            for (int r = 0; r < 4; ++r) rs[r] = rstd_from_parts(rstd, row0 + r);
            const int b = row0 / S_, t = row0 % S_;
#pragma unroll
            for (int ni = 0; ni < 4; ++ni) {
                const int cs = nb + ni * 16 + lc - (512 + (sec - 1) * 128);
                const int kvh = cs >> 6, d = cs & 63;
                uint2 pk; pk.x = pack2(acc[mi][ni][0] * rs[0], acc[mi][ni][1] * rs[1]); pk.y = pack2(acc[mi][ni][2] * rs[2], acc[mi][ni][3] * rs[3]);
                *(uint2*)(dst + (size_t)((b * 2 + kvh) * 64 + d) * S_ + t) = pk;
            }
        }
    }
    __device__ __forceinline__ void swapped(f32x4 (&acc)[4][4], int mb, int nb, int lane) const {
        const int lc = lane & 15, lq = lane >> 4;
        float kmx = 0.f;
        const bool is_q = nb < 512;
        const int sec = is_q ? 0 : ((nb - 512) >> 7) + 1;
        const bool rope_sec = nb < 1280 && (is_q || sec == 1 || sec == 3 || sec == 5);
        const bool knorm = nb < 1280 && (sec == 3 || sec == 5);
#pragma unroll
        for (int mi = 0; mi < 4; ++mi) {
            const int row = mb + mi * 16 + lc;
            const float rs = rstd_from_parts(rstd, row);
            float rowss = 0.f;
#pragma unroll
            for (int p = 0; p < 2; ++p) {
                ACC8(acc, mi, p, v);
#pragma unroll
                for (int e = 0; e < 8; ++e) v[e] *= rs;
                const int c0 = nb + p * 32 + lq * 8;
                if (nb < 1280) {
                    if (rope_sec && p == 0) {
                        float o[8];
#pragma unroll
                        for (int e = 0; e < 8; ++e) o[e] = __shfl_xor(v[e], 16);
                        if (lq < 2) {
                            const float4 r0 = *(const float4*)(rope + (size_t)row * 16), r1 = *(const float4*)(rope + (size_t)row * 16 + 4);
                            const float4 r2 = *(const float4*)(rope + (size_t)row * 16 + 8), r3 = *(const float4*)(rope + (size_t)row * 16 + 12);
                            const float cs_[8] = {r0.x, r0.z, r1.x, r1.z, r2.x, r2.z, r3.x, r3.z}, sn_[8] = {r0.y, r0.w, r1.y, r1.w, r2.y, r2.w, r3.y, r3.w};
#pragma unroll
                            for (int e = 0; e < 8; ++e) v[e] = (lq == 0) ? (v[e] * cs_[e] - o[e] * sn_[e]) : (o[e] * sn_[e] + v[e] * cs_[e]);
                        }
                    }
                    if (knorm) {
#pragma unroll
                        for (int e = 0; e < 8; ++e) rowss += v[e] * v[e];
                    }
                    const uint4 pk = pack8(v);
                    if (is_q) *(uint4*)(q + (size_t)row * 512 + c0) = pk;
                    else {
                        bf16_t* dst = sec == 1 ? kc : (sec == 2 ? vc : (sec == 3 ? ks : kw));
                        *(uint4*)(dst + (size_t)row * 128 + (c0 - (512 + (sec - 1) * 128))) = pk;
                    }
                } else if (nb < 1792) {
                    const int gI = ((nb - 1280) >> 3) + p * 4 + lq;
                    uint2 pk; pk.x = pack2(v[0] * sigmoidf_(v[4]), v[1] * sigmoidf_(v[5])); pk.y = pack2(v[2] * sigmoidf_(v[6]), v[3] * sigmoidf_(v[7]));
                    *(uint2*)(glu + (size_t)row * 256 + gI * 4) = pk;
                } else if (nb < 2048) {
                    *(uint4*)(zp + (size_t)row * 256 + (c0 - 1792)) = pack8(v);
                } else {
                    const int g0 = c0 - 2048;
                    if (g0 < 24) {
                        *(float4*)(gates + (size_t)row * 24 + g0) = make_float4(sigmoidf_(v[0]), sigmoidf_(v[1]), sigmoidf_(v[2]), sigmoidf_(v[3]));
                        *(float4*)(gates + (size_t)row * 24 + g0 + 4) = make_float4(sigmoidf_(v[4]), sigmoidf_(v[5]), sigmoidf_(v[6]), sigmoidf_(v[7]));
                    }
                }
            }
            if (knorm) { rowss += __shfl_xor(rowss, 16); rowss += __shfl_xor(rowss, 32); kmx = fmaxf(kmx, rowss); }
        }
        if (knorm) {
            kmx = row16_max(kmx);
            if (lane == 0) atomicMax(&knmax[sec == 3 ? 1 : 2], __float_as_uint(kmx));
        }
    }
};

struct EpiRes {
    bf16_t* xb; float* sumsq;
    __device__ __forceinline__ void operator()(f32x4 (&acc)[4][4], int mb, int nb, int lane) const {}
    __device__ __forceinline__ void swapped(f32x4 (&acc)[4][4], int mb, int nb, int lane) const {
        const int lc = lane & 15, lq = lane >> 4;
#pragma unroll
        for (int mi = 0; mi < 4; ++mi) {
            const int row = mb + mi * 16 + lc;
            float ss = 0.f;
#pragma unroll
            for (int p = 0; p < 2; ++p) {
                ACC8(acc, mi, p, v);
                const size_t idx = (size_t)row * DM + nb + p * 32 + lq * 8;
                const uint4 r = *(const uint4*)(xb + idx);
                v[0] += __uint_as_float(r.x << 16); v[1] += __uint_as_float(r.x & 0xFFFF0000u); v[2] += __uint_as_float(r.y << 16); v[3] += __uint_as_float(r.y & 0xFFFF0000u);
                v[4] += __uint_as_float(r.z << 16); v[5] += __uint_as_float(r.z & 0xFFFF0000u); v[6] += __uint_as_float(r.w << 16); v[7] += __uint_as_float(r.w & 0xFFFF0000u);
                *(uint4*)(xb + idx) = pack8(v);
#pragma unroll
                for (int e = 0; e < 8; ++e) ss += v[e] * v[e];
            }
            ss += __shfl_xor(ss, 16); ss += __shfl_xor(ss, 32);
            if (lq == 0) sumsq[(size_t)row * 16 + (nb >> 6)] = ss;
        }
    }
};

struct EpiScale {
    const float* sumsq; bf16_t* out; int ldo;
    __device__ __forceinline__ void operator()(f32x4 (&acc)[4][4], int mb, int nb, int lane) const {}
    __device__ __forceinline__ void swapped(f32x4 (&acc)[4][4], int mb, int nb, int lane) const {
        const int lc = lane & 15, lq = lane >> 4;
#pragma unroll
        for (int mi = 0; mi < 4; ++mi) {
            const int row = mb + mi * 16 + lc;
            const float rs = rstd_from_parts(sumsq, row);
#pragma unroll
            for (int p = 0; p < 2; ++p) {
                ACC8(acc, mi, p, v);
#pragma unroll
                for (int e = 0; e < 8; ++e) v[e] *= rs;
                *(uint4*)(out + (size_t)row * ldo + nb + p * 32 + lq * 8) = pack8(v);
            }
        }
    }
};

struct EpiMemKV {
    const float* rstd; bf16_t* kmem; bf16_t* vmemT; unsigned* kq;
    __device__ __forceinline__ void operator()(f32x4 (&acc)[4][4], int mb, int nb, int lane) const {
        const int lc = lane & 15, lq = lane >> 4;
#pragma unroll
        for (int mi = 0; mi < 4; ++mi) {
            const int row0 = mb + mi * 16 + lq * 4, b = row0 >> 8, m = row0 & 255;
            float rs[4];
#pragma unroll
            for (int r = 0; r < 4; ++r) rs[r] = rstd[row0 + r];
#pragma unroll
            for (int ni = 0; ni < 4; ++ni) {
                const int c2 = nb + ni * 16 + lc - 1024, h = c2 >> 8, d = c2 & 255;
                uint2 pk; pk.x = pack2(acc[mi][ni][0] * rs[0], acc[mi][ni][1] * rs[1]); pk.y = pack2(acc[mi][ni][2] * rs[2], acc[mi][ni][3] * rs[3]);
                *(uint2*)(vmemT + ((size_t)((b * 4 + h) * 256 + d)) * 256 + m) = pk;
            }
        }
    }
    __device__ __forceinline__ void swapped(f32x4 (&acc)[4][4], int mb, int nb, int lane) const {
        const int lc = lane & 15, lq = lane >> 4;
        float kmx = 0.f;
#pragma unroll
        for (int mi = 0; mi < 4; ++mi) {
            const int row = mb + mi * 16 + lc, b = row >> 8, m = row & 255;
            const float rs = rstd[row];
            float ss = 0.f;
#pragma unroll
            for (int p = 0; p < 2; ++p) {
                ACC8(acc, mi, p, v);
#pragma unroll
                for (int e = 0; e < 8; ++e) { v[e] *= rs; ss += v[e] * v[e]; }
                const int c0 = nb + p * 32 + lq * 8, h = c0 >> 8, d = c0 & 255;
                *(uint4*)(kmem + ((size_t)((b * 4 + h) * 256 + m)) * 256 + d) = pack8(v);
            }
            ss += __shfl_xor(ss, 16); ss += __shfl_xor(ss, 32);
            kmx = fmaxf(kmx, ss);
        }
        kmx = row16_max(kmx);
        if (lane == 0) atomicMax(kq, __float_as_uint(kmx));
    }
};

struct EpiCmp1 {
    float* part;
    __device__ __forceinline__ void operator()(f32x4 (&acc)[4][4], int mb, int nb, int lane) const {}
    __device__ __forceinline__ void swapped(f32x4 (&acc)[4][4], int mb, int nb, int lane) const {
        const int lc = lane & 15, lq = lane >> 4;
#pragma unroll
        for (int mi = 0; mi < 4; ++mi)
#pragma unroll
            for (int p = 0; p < 2; ++p) {
                float* d = part + (size_t)(mb + mi * 16 + lc) * 256 + nb + p * 32 + lq * 8;
                *(float4*)d = make_float4(acc[mi][2 * p][0], acc[mi][2 * p][1], acc[mi][2 * p][2], acc[mi][2 * p][3]);
                *(float4*)(d + 4) = make_float4(acc[mi][2 * p + 1][0], acc[mi][2 * p + 1][1], acc[mi][2 * p + 1][2], acc[mi][2 * p + 1][3]);
            }
    }
};

struct EpiCmp2 {
    int kv; bf16_t* kcmp; bf16_t* vcmpT; unsigned* knmax;
    __device__ __forceinline__ void operator()(f32x4 (&acc)[4][4], int mb, int nb, int lane) const {
        const int lc = lane & 15, lq = lane >> 4;
#pragma unroll
        for (int mi = 0; mi < 4; ++mi)
#pragma unroll
            for (int ni = 0; ni < 4; ++ni) {
                const int d = nb + ni * 16 + lc;
                if (d < 64) {
#pragma unroll
                    for (int r = 0; r < 4; ++r) {
                        const int row = mb + mi * 16 + lq * 4 + r;
                        if (row < 2040) {
                            const int kvh = row & 1, bn = row >> 1, b = bn / NCMP, n = bn - b * NCMP;
                            vcmpT[((size_t)((b * 2 + kvh) * 64 + d)) * 256 + n] = f2bf(acc[mi][ni][r]);
                        }
                    }
                }
            }
    }
    __device__ __forceinline__ void swapped(f32x4 (&acc)[4][4], int mb, int nb, int lane) const {
        const int lc = lane & 15, lq = lane >> 4;
        if (nb != 0) return;
        float kmx = 0.f;
#pragma unroll
        for (int mi = 0; mi < 4; ++mi) {
            const int row = mb + mi * 16 + lc;
            const bool ok = row < 2040;
            const int kvh = row & 1, bn = row >> 1, b = bn / NCMP, n = bn - b * NCMP;
            float ss = 0.f;
#pragma unroll
            for (int p = 0; p < 2; ++p) {
                ACC8(acc, mi, p, v);
#pragma unroll
                for (int e = 0; e < 8; ++e) ss += v[e] * v[e];
                if (ok) *(uint4*)(kcmp + ((size_t)((b * 2 + kvh) * 256 + n)) * 64 + p * 32 + lq * 8) = pack8(v);
            }
            ss += __shfl_xor(ss, 16); ss += __shfl_xor(ss, 32);
            if (ok) kmx = fmaxf(kmx, ss);
        }
        kmx = row16_max(kmx);
        if (lane == 0) atomicMax(&knmax[3], __float_as_uint(kmx));
    }
};

__device__ __forceinline__ void sort16_desc(unsigned (&a)[16]) {
#pragma unroll
    for (int k = 2; k <= 16; k <<= 1)
#pragma unroll
        for (int j = k >> 1; j > 0; j >>= 1)
#pragma unroll
            for (int i = 0; i < 16; ++i) {
                const int l = i ^ j;
                if (l > i) {
                    const unsigned hi = max(a[i], a[l]), lo = min(a[i], a[l]);
                    if ((i & k) == 0) { a[i] = hi; a[l] = lo; } else { a[i] = lo; a[l] = hi; }
                }
            }
}
__device__ __forceinline__ void merge16_desc(unsigned (&a)[16], const unsigned (&b)[16]) {
#pragma unroll
    for (int i = 0; i < 16; ++i) a[i] = max(a[i], b[15 - i]);
#pragma unroll
    for (int j = 8; j > 0; j >>= 1)
#pragma unroll
        for (int i = 0; i < 16; ++i) {
            const int l = i ^ j;
            if (l > i) { const unsigned hi = max(a[i], a[l]), lo = min(a[i], a[l]); a[i] = hi; a[l] = lo; }
        }
}

struct EpiPeerQ {
    const float* sumsq; const bf16_t* subk; unsigned short* eid; float* gate; char* smem;
    __device__ __forceinline__ void operator()(f32x4 (&acc)[4][4], int mb, int nb, int lane) const {}
    __device__ __forceinline__ void swapped(f32x4 (&acc)[4][4], int mb, int nb, int lane) const {
        const int tid = launder(threadIdx.x), w = __builtin_amdgcn_readfirstlane(tid >> 6), wr = w >> 1, wc = w & 1, lc = lane & 15, lq = lane >> 4;
        const int m0 = mb - wr * 64, n0 = nb - wc * 64;
        const int hp = n0 >> 7, pp = hp & 1;
        bf16_t* As = (bf16_t*)smem;
        bf16_t* Bs = As + 2 * 8192;
        {
            const int row_in = lane >> 3;
#pragma unroll
            for (int kt = 0; kt < 2; ++kt)
#pragma unroll
                for (int i = 0; i < 4; ++i) {
                    const int row = (w * 4 + i) * 8 + row_in;
                    const int gch = ((lane & 7) ^ swzr(row)) * 8;
                    glds16(subk + (size_t)pp * 128 * 128 + (size_t)row * 128 + kt * 64 + gch, Bs + kt * 8192 + (w * 4 + i) * 512);
                }
        }
#pragma unroll
        for (int mi = 0; mi < 4; ++mi) {
            const int rl = wr * 64 + mi * 16 + lc;
            const float rs = rstd_from_parts(sumsq, m0 + rl);
#pragma unroll
            for (int p = 0; p < 2; ++p) {
                ACC8(acc, mi, p, v);
#pragma unroll
                for (int e = 0; e < 8; ++e) v[e] *= rs;
                const int chunk = p * 4 + lq;
                *(uint4*)(As + wc * 8192 + swz64(rl, chunk)) = pack8(v);
            }
        }
        asm volatile("s_waitcnt vmcnt(0)" ::: "memory");
        __syncthreads();
        f32x4 sc[4][4];
#pragma unroll
        for (int i = 0; i < 4; ++i)
#pragma unroll
            for (int j = 0; j < 4; ++j) sc[i][j] = (f32x4){0.f, 0.f, 0.f, 0.f};
#pragma unroll
        for (int kt = 0; kt < 2; ++kt)
#pragma unroll
            for (int kk = 0; kk < 2; ++kk) {
                bf16x8 a[4], b[4];
                const int ch = kk * 4 + lq;
#pragma unroll
                for (int mi = 0; mi < 4; ++mi) a[mi] = *(const bf16x8*)(As + kt * 8192 + swz64(wr * 64 + mi * 16 + lc, ch));
#pragma unroll
                for (int ni = 0; ni < 4; ++ni) b[ni] = *(const bf16x8*)(Bs + kt * 8192 + swz64(wc * 64 + ni * 16 + lc, ch));
#pragma unroll
                for (int mi = 0; mi < 4; ++mi)
#pragma unroll
                    for (int ni = 0; ni < 4; ++ni) sc[mi][ni] = mfma16(a[mi], b[ni], sc[mi][ni]);
            }
        __syncthreads();
        unsigned* S = (unsigned*)smem;
#pragma unroll
        for (int mi = 0; mi < 4; ++mi)
#pragma unroll
            for (int ni = 0; ni < 4; ++ni)
#pragma unroll
                for (int r = 0; r < 4; ++r) {
                    const int row = wr * 64 + mi * 16 + lq * 4 + r, col = wc * 64 + ni * 16 + lc;
                    S[row * 128 + (col ^ (row & 31))] = (f2key(sc[mi][ni][r]) & ~127u) | (unsigned)col;
                }
        __syncthreads();
        const int row = tid >> 1, half = tid & 1;
        unsigned top[16];
#pragma unroll
        for (int c = 0; c < 4; ++c) {
            unsigned ch[16];
#pragma unroll
            for (int i = 0; i < 16; ++i) ch[i] = S[row * 128 + ((half * 64 + c * 16 + i) ^ (row & 31))];
            sort16_desc(ch);
            if (c == 0) {
#pragma unroll
                for (int i = 0; i < 16; ++i) top[i] = ch[i];
            } else merge16_desc(top, ch);
        }
        {
            unsigned oth[16];
#pragma unroll
            for (int k = 0; k < 16; ++k) oth[k] = __shfl_xor(top[k], 1);
            merge16_desc(top, oth);
        }
        unsigned* T0 = (unsigned*)(smem + 65536) + row * 16;
        if (half == 0) {
            if (pp == 0) {
#pragma unroll
                for (int k4 = 0; k4 < 4; ++k4) *(uint4*)(T0 + k4 * 4) = make_uint4(top[k4 * 4], top[k4 * 4 + 1], top[k4 * 4 + 2], top[k4 * 4 + 3]);
            } else {
                constexpr unsigned char CI[50] = {0,0,0,0,0,0,0,0,0,0,0,0,0,0,0,0, 1,1,1,1,1,1,1,1, 2,2,2,2,2, 3,3,3,3, 4,4,4, 5,5, 6,6, 7,7, 8,9,10,11,12,13,14,15};
                constexpr unsigned char CJ[50] = {0,1,2,3,4,5,6,7,8,9,10,11,12,13,14,15, 0,1,2,3,4,5,6,7, 0,1,2,3,4, 0,1,2,3, 0,1,2, 0,1, 0,1, 0,1, 0,0,0,0,0,0,0,0};
                float va[16], vb[16]; unsigned ia[16], ib[16];
#pragma unroll
                for (int i4 = 0; i4 < 4; ++i4) {
                    const uint4 a = *(const uint4*)(T0 + i4 * 4);
                    va[i4 * 4] = key2f(a.x); va[i4 * 4 + 1] = key2f(a.y); va[i4 * 4 + 2] = key2f(a.z); va[i4 * 4 + 3] = key2f(a.w);
                    ia[i4 * 4] = (a.x & 127u) << 7; ia[i4 * 4 + 1] = (a.y & 127u) << 7; ia[i4 * 4 + 2] = (a.z & 127u) << 7; ia[i4 * 4 + 3] = (a.w & 127u) << 7;
                }
#pragma unroll
                for (int i = 0; i < 16; ++i) { vb[i] = key2f(top[i]); ib[i] = top[i] & 127u; }
                unsigned best[16];
#pragma unroll
                for (int cb = 0; cb < 4; ++cb) {
                    unsigned ch[16];
#pragma unroll
                    for (int i = 0; i < 16; ++i) {
                        const int c = cb * 16 + i;
                        ch[i] = (c < 50) ? ((f2key(va[CI[c < 50 ? c : 0]] + vb[CJ[c < 50 ? c : 0]]) & ~16383u) | ia[CI[c < 50 ? c : 0]] | ib[CJ[c < 50 ? c : 0]]) : 0u;
                    }
                    sort16_desc(ch);
                    if (cb == 0) {
#pragma unroll
                        for (int i = 0; i < 16; ++i) best[i] = ch[i];
                    } else merge16_desc(best, ch);
                }
                float e[16]; float dsum = 0.f;
                const unsigned k0 = best[0] & ~16383u;
                const float s0 = __uint_as_float((k0 & 0x80000000u) ? (k0 ^ 0x80000000u) : ~k0);
#pragma unroll
                for (int r = 0; r < 16; ++r) {
                    const unsigned kk = best[r] & ~16383u;
                    const float s = __uint_as_float((kk & 0x80000000u) ? (kk ^ 0x80000000u) : ~kk);
                    e[r] = __expf(s - s0); dsum += e[r];
                }
                const float inv = 1.f / dsum;
                const size_t pr = (size_t)(m0 + row) * 8 + (hp >> 1);
                uint4 o0, o1;
                o0.x = (best[0] & 16383u) | ((best[1] & 16383u) << 16); o0.y = (best[2] & 16383u) | ((best[3] & 16383u) << 16);
                o0.z = (best[4] & 16383u) | ((best[5] & 16383u) << 16); o0.w = (best[6] & 16383u) | ((best[7] & 16383u) << 16);
                o1.x = (best[8] & 16383u) | ((best[9] & 16383u) << 16); o1.y = (best[10] & 16383u) | ((best[11] & 16383u) << 16);
                o1.z = (best[12] & 16383u) | ((best[13] & 16383u) << 16); o1.w = (best[14] & 16383u) | ((best[15] & 16383u) << 16);
                *(uint4*)(eid + pr * 16) = o0; *(uint4*)(eid + pr * 16 + 8) = o1;
#pragma unroll
                for (int r4 = 0; r4 < 4; ++r4)
                    *(float4*)(gate + pr * 16 + r4 * 4) = make_float4(e[r4 * 4] * inv, e[r4 * 4 + 1] * inv, e[r4 * 4 + 2] * inv, e[r4 * 4 + 3] * inv);
            }
        }
        __syncthreads();
    }
};

__device__ __forceinline__ int win_colmap(int n) {
    if (n < 1280) return n;
    if (n < 1792) { const int j = n - 1280, gI = j >> 3, w8 = j & 7, ch = gI * 4 + (w8 & 3); return (w8 & 4) ? 1560 + ch : 1304 + ch; }
    if (n < 2048) return 1816 + (n - 1792);
    if (n < 2072) return 1280 + (n - 2048);
    return -1;
}
template <bool WINMAP>
__device__ __forceinline__ void tconv(const float* __restrict__ src, int ld_src, int K, int Nd, const float* __restrict__ g, bf16_t* __restrict__ dst,
                                      int tid, int bid, int G, int& base, float* tl  ) {
    const int nkt = K >> 6, ntiles = (Nd >> 6) * nkt;
    const int first = (bid + G - (base % G)) % G;
    for (int t = first; t < ntiles; t += G) {
        const int n0 = (t / nkt) * 64, k0 = (t % nkt) * 64;
        {
            const int kr = tid >> 4, nc = (tid & 15) * 4;
            const int n = n0 + nc;
            const int sc = WINMAP ? win_colmap(n) : n;
#pragma unroll
            for (int ps = 0; ps < 4; ++ps) {
                const int k = kr + ps * 16;
                float4 v = make_float4(0.f, 0.f, 0.f, 0.f);
                if (sc >= 0) v = *(const float4*)(src + (size_t)(k0 + k) * ld_src + sc);
                tl[k * 65 + nc] = v.x; tl[k * 65 + nc + 1] = v.y; tl[k * 65 + nc + 2] = v.z; tl[k * 65 + nc + 3] = v.w;
            }
        }
        __syncthreads();
        {
            const int n = tid >> 2, kq = (tid & 3) * 16;
            float v[16];
#pragma unroll
            for (int i = 0; i < 16; ++i) v[i] = tl[(kq + i) * 65 + n] * (g ? g[k0 + kq + i] : 1.f);
            uint4 o0, o1;
            o0.x = pack2(v[0], v[1]); o0.y = pack2(v[2], v[3]); o0.z = pack2(v[4], v[5]); o0.w = pack2(v[6], v[7]);
            o1.x = pack2(v[8], v[9]); o1.y = pack2(v[10], v[11]); o1.z = pack2(v[12], v[13]); o1.w = pack2(v[14], v[15]);
            bf16_t* d = dst + (size_t)(n0 + n) * K + k0 + kq;
            *(uint4*)d = o0; *(uint4*)(d + 8) = o1;
        }
        __syncthreads();
    }
    base += ntiles;
}
__device__ __forceinline__ void conv_bf16(const float* __restrict__ src, bf16_t* __restrict__ dst, size_t n, int gtid, int gsize) {
    const size_t n8 = n >> 3;
    for (size_t i = gtid; i < n8; i += gsize) {
        const float4 a = *(const float4*)(src + i * 8), b = *(const float4*)(src + i * 8 + 4);
        uint4 o; o.x = pack2(a.x, a.y); o.y = pack2(a.z, a.w); o.z = pack2(b.x, b.y); o.w = pack2(b.z, b.w);
        *(uint4*)(dst + i * 8) = o;
    }
}
constexpr float U_SCALE = 64.f, V_SCALE = 5.657f;
template<bool PERM>
__device__ __forceinline__ void conv_fp4(const float* __restrict__ src, unsigned char* __restrict__ dst, size_t n, float scale, int gtid, int gsize) {
    const size_t n32 = n >> 5;
    for (size_t o = gtid; o < n32; o += gsize) {
        const size_t row = o >> 5; const int un = (int)(o & 31);
        const float* s = src + row * 1024 + (PERM ? (un >> 4) * 512 + (un & 15) * 8 : un * 32);
        unsigned wd[4];
#pragma unroll
        for (int k = 0; k < 4; ++k) {
            const float* sk = s + k * (PERM ? 128 : 8);
            const float4 a = *(const float4*)sk, b = *(const float4*)(sk + 4);
            unsigned w = 0u;
            w = __builtin_amdgcn_cvt_scalef32_pk_fp4_f32(w, a.x * scale, a.y * scale, 1.0f, 0);
            w = __builtin_amdgcn_cvt_scalef32_pk_fp4_f32(w, a.z * scale, a.w * scale, 1.0f, 1);
            w = __builtin_amdgcn_cvt_scalef32_pk_fp4_f32(w, b.x * scale, b.y * scale, 1.0f, 2);
            w = __builtin_amdgcn_cvt_scalef32_pk_fp4_f32(w, b.z * scale, b.w * scale, 1.0f, 3);
            wd[k] = w;
        }
        *(uint4*)(dst + o * 16) = make_uint4(wd[0], wd[1], wd[2], wd[3]);
    }
}
__device__ __forceinline__ void row_prep(const float* __restrict__ src, bf16_t* __restrict__ dstb, float* __restrict__ rstd, float* __restrict__ parts, int nrows, int gwave, int nwaves, int lane) {
    for (int row = gwave; row < nrows; row += nwaves) {
        const float* p = src + (size_t)row * DM + lane * 16;
        float v[16]; float ss = 0.f;
#pragma unroll
        for (int i = 0; i < 4; ++i) { const float4 t = *(const float4*)(p + i * 4); v[i * 4] = t.x; v[i * 4 + 1] = t.y; v[i * 4 + 2] = t.z; v[i * 4 + 3] = t.w; }
#pragma unroll
        for (int i = 0; i < 16; ++i) ss += v[i] * v[i];
        float s4 = ss + __shfl_xor(ss, 1); s4 += __shfl_xor(s4, 2);
        if (parts && (lane & 3) == 0) parts[(size_t)row * 16 + (lane >> 2)] = s4;
        ss = wave_sum(ss);
        uint4 o0, o1;
        o0.x = pack2(v[0], v[1]); o0.y = pack2(v[2], v[3]); o0.z = pack2(v[4], v[5]); o0.w = pack2(v[6], v[7]);
        o1.x = pack2(v[8], v[9]); o1.y = pack2(v[10], v[11]); o1.z = pack2(v[12], v[13]); o1.w = pack2(v[14], v[15]);
        *(uint4*)(dstb + (size_t)row * DM + lane * 16) = o0;
        *(uint4*)(dstb + (size_t)row * DM + lane * 16 + 8) = o1;
        if (rstd && lane == 0) rstd[row] = rsqrtf(ss * (1.f / DM) + EPS);
    }
}
__device__ __forceinline__ void sincos_d(double ang, float& c, float& s) {
    const double k = rint(ang * 0.63661977236758134308);
    double r = fma(-k, 1.57079632679489655800e+00, ang);
    r = fma(-k, 6.12323399573676603587e-17, r);
    const double r2 = r * r;
    double sp = -1.0 / 39916800.0; sp = fma(sp, r2, 1.0 / 362880.0); sp = fma(sp, r2, -1.0 / 5040.0); sp = fma(sp, r2, 1.0 / 120.0); sp = fma(sp, r2, -1.0 / 6.0); sp = fma(sp, r2, 1.0);
    const double sn = sp * r;
    double cp = 1.0 / 479001600.0; cp = fma(cp, r2, -1.0 / 3628800.0); cp = fma(cp, r2, 1.0 / 40320.0); cp = fma(cp, r2, -1.0 / 720.0); cp = fma(cp, r2, 1.0 / 24.0); cp = fma(cp, r2, -0.5); cp = fma(cp, r2, 1.0);
    const int q = ((int)k) & 3;
    double cc, ss;
    if (q == 0) { cc = cp; ss = sn; } else if (q == 1) { cc = -sn; ss = cp; } else if (q == 2) { cc = -cp; ss = -sn; } else { cc = sn; ss = -cp; }
    c = (float)cc; s = (float)ss;
}

__device__ __forceinline__ void conv_weights(const Params& p, int l, int mask, char* smem) {
    const int tid0 = launder(threadIdx.x);
    const int gtid = blockIdx.x * NTHREADS + tid0, gsize = gridDim.x * NTHREADS;
    char* ws = launder_p(p.ws);
    int tbase = 0;
    float* tl = (float*)smem;
    const int bid_ = blockIdx.x, G_ = gridDim.x;
    char* W = ws + WS_W + l * W_STRIDE;
    __syncthreads();
    if (mask & 1) tconv<true >(p.in[4] + (size_t)l * 1024 * 2072, 2072, 1024, NWIN, p.in[3] + l * 1024, (bf16_t*)(W + W_WIN), tid0, bid_, G_, tbase, tl);
    if (mask & 2) tconv<false>(p.in[20] + (size_t)l * 1024 * 2048, 2048, 1024, 2048, p.in[18] + l * 1024, (bf16_t*)(W + W_XWKV), tid0, bid_, G_, tbase, tl);
    if (mask & 4) {
        tconv<false>(p.in[16] + (size_t)l * 1024 * 1024, 1024, 1024, 1024, nullptr, (bf16_t*)(W + W_WOUT), tid0, bid_, G_, tbase, tl);
        tconv<false>(p.in[19] + (size_t)l * 1024 * 1024, 1024, 1024, 1024, p.in[17] + l * 1024, (bf16_t*)(W + W_XWQ), tid0, bid_, G_, tbase, tl);
        tconv<false>(p.in[21] + (size_t)l * 1024 * 1024, 1024, 1024, 1024, nullptr, (bf16_t*)(W + W_XWO), tid0, bid_, G_, tbase, tl);
        tconv<false>(p.in[23] + (size_t)l * 1024 * 2048, 2048, 1024, 2048, p.in[22] + l * 1024, (bf16_t*)(W + W_PWQ), tid0, bid_, G_, tbase, tl);
        for (int kv = 0; kv < 2; ++kv) {
            tconv<false>(p.in[6] + ((size_t)l * 2 + kv) * 2048 * 256, 256, 2048, 256, nullptr, (bf16_t*)(W + W_CW1) + (size_t)kv * 256 * 2048, tid0, bid_, G_, tbase, tl);
            tconv<false>(p.in[7] + ((size_t)l * 2 + kv) * 256 * 64, 64, 256, 64, nullptr, (bf16_t*)(W + W_CW2) + (size_t)kv * 64 * 256, tid0, bid_, G_, tbase, tl);
        }
        tconv<false>(p.in[12] + (size_t)l * 256 * 256, 256, 256, 256, nullptr, (bf16_t*)(W + W_PW), tid0, bid_, G_, tbase, tl);
        for (int g = 0; g < 4; ++g)
            tconv<false>(p.in[14] + ((size_t)l * 4 + g) * 64 * 64, 64, 64, 64, nullptr, (bf16_t*)(W + W_POOLW) + (size_t)g * 64 * 64, tid0, bid_, G_, tbase, tl);
        conv_bf16(p.in[24] + (size_t)l * 2 * 128 * 128, (bf16_t*)(W + W_SUBK), 2 * 128 * 128, gtid, gsize);
    }
    if (mask & 8) {
        for (int u = bid_; u < 64; u += G_) {
            const int kv = u >> 5, kc = u & 31;
            const float* pe = p.in[5] + ((size_t)l * 2 + kv) * 2048 + kc * 64;
            const float* w1 = p.in[6] + ((size_t)l * 2 + kv) * 2048 * 256 + (size_t)kc * 64 * 256;
            float s = 0.f;
            for (int k = 0; k < 64; ++k) s += pe[k] * w1[(size_t)k * 256 + tid0];
            ((float*)(ws + WS_CBPART))[((size_t)(l * 2 + kv) * 32 + kc) * 256 + tid0] = s;
        }
    }
    __syncthreads();
}

__device__ __forceinline__ void phase_prep(const Params& p, char* smem) {
    const int tid0 = launder(threadIdx.x);
    const int gtid = blockIdx.x * NTHREADS + tid0, gsize = gridDim.x * NTHREADS;
    const int lane = tid0 & 63, gwave = gtid >> 6, nwaves = gsize >> 6;
    char* ws = launder_p(p.ws);
    conv_weights(p, 0, 1 | 2 | 8, smem);
    conv_weights(p, 1, 2, smem);
    row_prep(p.in[0], (bf16_t*)(ws + WS_XB), nullptr, (float*)(ws + WS_PARTS0), T_, gwave, nwaves, lane);
    row_prep(p.in[1], (bf16_t*)(ws + WS_MEMB), (float*)(ws + WS_RSTDM), nullptr, 1024, gwave, nwaves, lane);
    const int* pos = (const int*)p.in[2];
    float* rope = (float*)(ws + WS_ROPE);
    for (int i = gtid; i < T_ * 8; i += gsize) {
        const int t = i >> 3, f = i & 7;
        float c, s; sincos_d((double)pos[t] * p.freq[f], c, s);
        rope[(size_t)t * 16 + f * 2] = c; rope[(size_t)t * 16 + f * 2 + 1] = s;
    }
    if (gtid < 8) ((unsigned*)(ws + WS_KNMAX))[gtid] = 0u;
    unsigned* kz = (unsigned*)(ws + WS_KCMP);
    for (int i = gtid; i < (512 * 1024) / 4; i += gsize) kz[i] = 0u;
}

__device__ __forceinline__ void convpool_tile(const Params& p, int l, int item, char* smem) {
    const int tid = launder(threadIdx.x), lane = tid & 63, w = tid >> 6;
    char* ws = launder_p(p.ws); char* W = ws + WS_W + l * W_STRIDE;
    const int t0 = item * 16, b = t0 / S_, s0 = t0 % S_;
    const bf16_t* glu = (const bf16_t*)(ws + WS_GLU);
    const bf16_t* zp = (const bf16_t*)(ws + WS_ZP);
    bf16_t* mix = (bf16_t*)(ws + WS_MIX);
    bf16_t* gw = (bf16_t*)smem;
    bf16_t* zw = gw + 46 * 256;
    float* ybuf = (float*)(smem + 23552 + 15872);
    bf16_t* at = (bf16_t*)(smem + 23552 + 15872 + 16384);
    uint4 wg[6], wz[4];
#pragma unroll
    for (int i = 0; i < 6; ++i) {
        const int c = tid + i * NTHREADS, r = c >> 5, ch = c & 31, s = s0 - 30 + r;
        wg[i] = make_uint4(0u, 0u, 0u, 0u);
        if (c < 46 * 32 && s >= 0) wg[i] = *(const uint4*)(glu + ((size_t)(b * S_ + s)) * 256 + ch * 8);
    }
#pragma unroll
    for (int i = 0; i < 4; ++i) {
        const int c = tid + i * NTHREADS, r = c >> 5, ch = c & 31, s = s0 - 15 + r;
        wz[i] = make_uint4(0u, 0u, 0u, 0u);
        if (c < 31 * 32 && s >= 0) wz[i] = *(const uint4*)(zp + ((size_t)(b * S_ + s)) * 256 + ch * 8);
    }
    const float* cw = p.in[8] + (size_t)l * 31 * 256;
    float wk[31];
#pragma unroll
    for (int k = 0; k < 31; ++k) wk[k] = cw[k * 256 + tid];
    const float cb = p.in[9][l * 256 + tid];
#pragma unroll
    for (int i = 0; i < 6; ++i) { const int c = tid + i * NTHREADS; if (c < 46 * 32) *(uint4*)(gw + (c >> 5) * 256 + (c & 31) * 8) = wg[i]; }
#pragma unroll
    for (int i = 0; i < 4; ++i) { const int c = tid + i * NTHREADS; if (c < 31 * 32) *(uint4*)(zw + (c >> 5) * 256 + (c & 31) * 8) = wz[i]; }
    const bf16_t* pw = (const bf16_t*)(W + W_PW);
    bf16x8 bb[8][4];
#pragma unroll
    for (int kk = 0; kk < 8; ++kk)
#pragma unroll
        for (int ni = 0; ni < 4; ++ni) bb[kk][ni] = *(const bf16x8*)(pw + (size_t)(w * 64 + ni * 16 + (lane & 15)) * 256 + kk * 32 + (lane >> 4) * 8);
    __syncthreads();
    {
        const int c = tid;
        float a[16];
#pragma unroll
        for (int tl = 0; tl < 16; ++tl) a[tl] = cb;
#pragma unroll
        for (int r = 0; r < 46; ++r) {
            const float g = bf2f(gw[r * 256 + c]);
#pragma unroll
            for (int tl = 0; tl < 16; ++tl) { const int k = r - tl; if (k >= 0 && k < 31) a[tl] += wk[k] * g; }
        }
#pragma unroll
        for (int tl = 0; tl < 16; ++tl) ybuf[tl * 256 + c] = a[tl];
    }
    __syncthreads();
    {
        const float* lg = p.in[10] + l * 256; const float* lb = p.in[11] + l * 256;
        const float4 g4 = *(const float4*)(lg + lane * 4), b4 = *(const float4*)(lb + lane * 4);
#pragma unroll 1
        for (int tl = w * 4; tl < w * 4 + 4; ++tl) {
            const float4 v = *(const float4*)(ybuf + tl * 256 + lane * 4);
            const float mean = wave_sum(v.x + v.y + v.z + v.w) * (1.f / 256.f);
            const float d0 = v.x - mean, d1 = v.y - mean, d2 = v.z - mean, d3 = v.w - mean;
            const float var = wave_sum(d0 * d0 + d1 * d1 + d2 * d2 + d3 * d3) * (1.f / 256.f);
            const float rs = rsqrtf(var + EPS);
            float y0 = d0 * rs * g4.x + b4.x, y1 = d1 * rs * g4.y + b4.y, y2 = d2 * rs * g4.z + b4.z, y3 = d3 * rs * g4.w + b4.w;
            y0 *= sigmoidf_(y0); y1 *= sigmoidf_(y1); y2 *= sigmoidf_(y2); y3 *= sigmoidf_(y3);
            uint2 o; o.x = pack2(y0, y1); o.y = pack2(y2, y3);
            *(uint2*)(at + tl * 264 + lane * 4) = o;
        }
    }
    __syncthreads();
    {
        f32x4 acc[4];
#pragma unroll
        for (int j = 0; j < 4; ++j) acc[j] = (f32x4){0.f, 0.f, 0.f, 0.f};
#pragma unroll
        for (int kk = 0; kk < 8; ++kk) {
            const bf16x8 av = *(const bf16x8*)(at + (lane & 15) * 264 + kk * 32 + (lane >> 4) * 8);
#pragma unroll
            for (int ni = 0; ni < 4; ++ni) acc[ni] = mfma16(bb[kk][ni], av, acc[ni]);
        }
        const float* pb = p.in[13] + l * 256;
#pragma unroll
        for (int ni = 0; ni < 4; ++ni) {
            const int col = w * 64 + ni * 16 + (lane >> 4) * 4; const float4 bv = *(const float4*)(pb + col);
            *(uint2*)(mix + (size_t)(t0 + (lane & 15)) * DM + 512 + col) = make_uint2(pack2(acc[ni][0] + bv.x, acc[ni][1] + bv.y), pack2(acc[ni][2] + bv.z, acc[ni][3] + bv.w));
        }
    }
    __syncthreads();
    const int gi = w;
    const bf16_t* pwt = (const bf16_t*)(W + W_POOLW) + (size_t)gi * 64 * 64;
    bf16x8 pbb[2][4];
#pragma unroll
    for (int kk = 0; kk < 2; ++kk)
#pragma unroll
        for (int ni = 0; ni < 4; ++ni) pbb[kk][ni] = *(const bf16x8*)(pwt + (size_t)(ni * 16 + (lane & 15)) * 64 + kk * 32 + (lane >> 4) * 8);
    {
        const int c = tid, win = 2 << gi;
#pragma unroll 1
        for (int tl = 0; tl < 16; ++tl) {
            const int s = s0 + tl; const int cnt = (s + 1 < win) ? (s + 1) : win;
            float sum = 0.f;
            for (int k = 0; k < cnt; ++k) sum += bf2f(zw[(15 + tl - k) * 256 + c]);
            const float m = sum / (float)cnt - bf2f(zw[(15 + tl) * 256 + c]);
            at[tl * 264 + c] = f2bf(m);
        }
    }
    __syncthreads();
    {
        f32x4 acc[4];
#pragma unroll
        for (int j = 0; j < 4; ++j) acc[j] = (f32x4){0.f, 0.f, 0.f, 0.f};
#pragma unroll
        for (int kk = 0; kk < 2; ++kk) {
            const bf16x8 av = *(const bf16x8*)(at + (lane & 15) * 264 + gi * 64 + kk * 32 + (lane >> 4) * 8);
#pragma unroll
            for (int ni = 0; ni < 4; ++ni) acc[ni] = mfma16(pbb[kk][ni], av, acc[ni]);
        }
        const float* psc = p.in[15] + l * 256;
#pragma unroll
        for (int ni = 0; ni < 4; ++ni) {
            const int col = gi * 64 + ni * 16 + (lane >> 4) * 4; const float4 sc = *(const float4*)(psc + col);
            *(uint2*)(mix + (size_t)(t0 + (lane & 15)) * DM + 768 + col) = make_uint2(pack2(acc[ni][0] * sc.x, acc[ni][1] * sc.y), pack2(acc[ni][2] * sc.z, acc[ni][3] * sc.w));
        }
    }
    __syncthreads();
}

struct FlashState { float lp[2]; f32x4 o[4][2]; };

__device__ __forceinline__ void nsa_issue_tile(const bf16_t* __restrict__ ksrc, int kstride, const bf16_t* __restrict__ vtsrc, int vtstride, bf16_t* Kt, bf16_t* Vt, int w, int lane) {
    const int row_in = lane >> 3, gch = ((lane & 7) ^ row_in) * 8;
#pragma unroll
    for (int i = 0; i < 2; ++i) {
        const int piece = w * 2 + i, row = piece * 8 + row_in;
        glds16(ksrc + (size_t)row * kstride + gch, Kt + piece * 512);
        glds16(vtsrc + (size_t)row * vtstride + gch, Vt + piece * 512);
    }
}

template <int KIND, bool STATS_ONLY, bool NORMALIZE>
__device__ __forceinline__ void nsa_tile_step(FlashState& st, const bf16x8 (&qa)[2][2], const bf16_t* Kt, const bf16_t* Vt, bf16_t* Pw, int lane,
                                              int j, int pos0, const unsigned long long* mask64, const int* nmaxv, const float (&mb2)[2], const float (&invl)[2]) {
    const int lc = lane & 15, lq = lane >> 4;
    constexpr float C2 = 0.125f * 1.4426950408889634f;
    bf16x8 kb[4][2];
#pragma unroll
    for (int ni = 0; ni < 4; ++ni)
#pragma unroll
        for (int kk = 0; kk < 2; ++kk) kb[ni][kk] = *(const bf16x8*)(Kt + (ni * 16 + lc) * 64 + (((kk * 4 + lq) ^ (lc & 7)) << 3));
    bf16x8 pb[2][2];
#pragma unroll
    for (int mi = 0; mi < 2; ++mi) {
        f32x4 s[4];
#pragma unroll
        for (int ni = 0; ni < 4; ++ni) {
            s[ni] = (f32x4){0.f, 0.f, 0.f, 0.f};
            s[ni] = mfma16(kb[ni][0], qa[mi][0], s[ni]);
            s[ni] = mfma16(kb[ni][1], qa[mi][1], s[ni]);
        }
        const int tl = mi * 16 + lc;
        bool rowsel = true; int lim = 0;
        if (KIND == 1) rowsel = (mask64[tl] >> j) & 1ull;
        if (KIND == 2 || KIND == 3) lim = pos0 + tl;
        if (KIND == 4) lim = nmaxv[tl] - j * 64;
        float p[4][4]; float psum = 0.f;
#pragma unroll
        for (int ni = 0; ni < 4; ++ni)
#pragma unroll
            for (int r = 0; r < 4; ++r) {
                const int kl = ni * 16 + lq * 4 + r;
                const float e = __builtin_amdgcn_exp2f(fmaf(s[ni][r], C2, -mb2[mi]));
                bool ok = true;
                if (KIND == 1) ok = rowsel;
                if (KIND == 2 || KIND == 4) ok = kl <= lim;
                if (KIND == 3) ok = kl > lim;
                float pv = ok ? e : 0.f;
                if (NORMALIZE) pv *= invl[mi];
                p[ni][r] = pv; psum += pv;
            }
        if (!NORMALIZE) st.lp[mi] += psum;
        if (!STATS_ONLY) {
#pragma unroll
            for (int sx = 0; sx < 2; ++sx) {
                const unsigned w0 = pack2(p[2 * sx][0], p[2 * sx][1]), w1 = pack2(p[2 * sx][2], p[2 * sx][3]);
                const unsigned w2 = pack2(p[2 * sx + 1][0], p[2 * sx + 1][1]), w3 = pack2(p[2 * sx + 1][2], p[2 * sx + 1][3]);
                const uint4 pk = make_uint4(w0, w1, w2, w3);
                pb[mi][sx] = __builtin_bit_cast(bf16x8, pk);
                if (NORMALIZE) {
                    *(uint2*)(Pw + tl * 72 + (2 * sx) * 16 + lq * 4) = make_uint2(w0, w1);
                    *(uint2*)(Pw + tl * 72 + (2 * sx + 1) * 16 + lq * 4) = make_uint2(w2, w3);
                }
            }
        }
    }
    if (!STATS_ONLY) {
#pragma unroll
        for (int nd = 0; nd < 4; ++nd) {
            const int row = nd * 16 + lc;
            bf16x8 va[2];
#pragma unroll
            for (int sx = 0; sx < 2; ++sx) {
                const int c0 = 4 * sx + (lq >> 1), c1 = c0 + 2;
                const uint2 lo = *(const uint2*)(Vt + row * 64 + ((c0 ^ (lc & 7)) << 3) + (lq & 1) * 4);
                const uint2 hi = *(const uint2*)(Vt + row * 64 + ((c1 ^ (lc & 7)) << 3) + (lq & 1) * 4);
                va[sx] = __builtin_bit_cast(bf16x8, make_uint4(lo.x, lo.y, hi.x, hi.y));
            }
#pragma unroll
            for (int mi = 0; mi < 2; ++mi) {
                st.o[nd][mi] = mfma16(va[0], pb[mi][0], st.o[nd][mi]);
                st.o[nd][mi] = mfma16(va[1], pb[mi][1], st.o[nd][mi]);
            }
        }
    }
}

__device__ __forceinline__ void flash_reset(FlashState& st) {
    st.lp[0] = 0.f; st.lp[1] = 0.f;
#pragma unroll
    for (int nd = 0; nd < 4; ++nd)
#pragma unroll
        for (int mi = 0; mi < 2; ++mi) st.o[nd][mi] = (f32x4){0.f, 0.f, 0.f, 0.f};
}

template <bool FIRST, bool NORMALIZED>
__device__ __forceinline__ void nsa_emit(const FlashState& st, const float* __restrict__ gates, bf16_t* __restrict__ mix, int tok0, int kvh, int g, int gidx, int lane_) {
    const int lane = launder(lane_);
    const int lc = lane & 15, lq = lane >> 4;
#pragma unroll
    for (int mi = 0; mi < 2; ++mi) {
        const int t = tok0 + mi * 16 + lc;
        const float gt = gates[(size_t)t * 24 + kvh * 12 + g * 3 + gidx];
        float sc;
        if (NORMALIZED) sc = gt;
        else { float l = st.lp[mi]; l += __shfl_xor(l, 16); l += __shfl_xor(l, 32); sc = l > 0.f ? gt / l : 0.f; }
#pragma unroll
        for (int nd = 0; nd < 4; ++nd) {
            bf16_t* dst = mix + (size_t)t * DM + (kvh * 4 + g) * 64 + nd * 16 + lq * 4;
            float v0 = st.o[nd][mi][0] * sc, v1 = st.o[nd][mi][1] * sc, v2 = st.o[nd][mi][2] * sc, v3 = st.o[nd][mi][3] * sc;
            if (!FIRST) { const uint2 old = *(const uint2*)dst;
                v0 += __uint_as_float(old.x << 16); v1 += __uint_as_float(old.x & 0xFFFF0000u); v2 += __uint_as_float(old.y << 16); v3 += __uint_as_float(old.y & 0xFFFF0000u); }
            *(uint2*)dst = make_uint2(pack2(v0, v1), pack2(v2, v3));
        }
    }
}

__device__ __forceinline__ void nsa_item(const Params& p, int l, int item, char* smem) {
    const int tid = launder(threadIdx.x), lane = tid & 63, g = tid >> 6;
    char* ws = launder_p(p.ws);
    const int qi = 127 - (item >> 3), bk = item & 7, b = bk >> 1, kvh = bk & 1;
    const int cur = qi >> 1, pos0 = (qi & 1) * 32;
    const int tok0 = b * S_ + qi * 32;
    bf16_t* Kb = (bf16_t*)smem;
    bf16_t* Vb = Kb + 2 * 4096;
    bf16_t* Pall = Vb + 2 * 4096;
    bf16_t* Pw = Pall + g * 2304;
    float* impf = (float*)(smem + 32768 + 18432);
    unsigned long long* mask64 = (unsigned long long*)(smem + 32768 + 18432 + 8192);
    int* nmaxv = (int*)(smem + 32768 + 18432 + 8192 + 256);
    float* qnl = (float*)(smem + 32768 + 18432 + 8192 + 512) + g * 32;
    const int wv = __builtin_amdgcn_readfirstlane(g);
    const bf16_t* q = (const bf16_t*)(ws + WS_Q);
    const float* gates = (const float*)(ws + WS_GATES);
    bf16_t* mix = (bf16_t*)(ws + WS_MIX);
    unsigned* knm = (unsigned*)(ws + WS_KNMAX) + l * 4;
    constexpr float C2 = 0.125f * 1.4426950408889634f;

    bf16x8 qa[2][2];
#pragma unroll
    for (int mi = 0; mi < 2; ++mi)
#pragma unroll
        for (int kk = 0; kk < 2; ++kk)
            qa[mi][kk] = *(const bf16x8*)(q + (size_t)(tok0 + mi * 16 + (lane & 15)) * 512 + (kvh * 4 + g) * 64 + kk * 32 + (lane >> 4) * 8);
    float qn2[2];
#pragma unroll
    for (int mi = 0; mi < 2; ++mi) {
        float ss = 0.f;
#pragma unroll
        for (int kk = 0; kk < 2; ++kk)
#pragma unroll
            for (int e = 0; e < 8; ++e) { const float f = bf2f((bf16_t)qa[mi][kk][e]); ss += f * f; }
        ss += __shfl_xor(ss, 16); ss += __shfl_xor(ss, 32);
        qn2[mi] = sqrtf(ss) * C2;
    }
    const float kmax_cmp = sqrtf(__uint_as_float(__hip_atomic_load(knm + 3, __ATOMIC_RELAXED, __HIP_MEMORY_SCOPE_AGENT)));
    const float kmax_sel = sqrtf(__uint_as_float(__hip_atomic_load(knm + 1, __ATOMIC_RELAXED, __HIP_MEMORY_SCOPE_AGENT)));
    const float kmax_win = sqrtf(__uint_as_float(__hip_atomic_load(knm + 2, __ATOMIC_RELAXED, __HIP_MEMORY_SCOPE_AGENT)));

    for (int i = tid; i < 32 * 64; i += NTHREADS) impf[i] = 0.f;
    if (tid < 32) { const int t = qi * 32 + tid; nmaxv[tid] = (t >= 31) ? min((t - 31) >> 4, NCMP - 1) : -1; }
    const int tmax = qi * 32 + 31;
    const int ncmp_tiles = (min((tmax - 31) >> 4, NCMP - 1) >> 6) + 1;
    const bf16_t* kcmp = (const bf16_t*)(ws + WS_KCMP) + (size_t)(b * 2 + kvh) * 256 * 64;
    const bf16_t* vcmpT = (const bf16_t*)(ws + WS_VCMPT) + (size_t)(b * 2 + kvh) * 64 * 256;

    FlashState st;
    flash_reset(st);
    float mb2[2], invl[2];
    mb2[0] = qn2[0] * kmax_cmp; mb2[1] = qn2[1] * kmax_cmp; invl[0] = 0.f; invl[1] = 0.f;
    nsa_issue_tile(kcmp, 64, vcmpT, 256, Kb, Vb, wv, lane);
    for (int j = 0; j < ncmp_tiles; ++j) {
        asm volatile("s_waitcnt vmcnt(0)" ::: "memory");
        __syncthreads();
        if (j + 1 < ncmp_tiles) nsa_issue_tile(kcmp + (size_t)(j + 1) * 64 * 64, 64, vcmpT + (j + 1) * 64, 256, Kb + ((j + 1) & 1) * 4096, Vb + ((j + 1) & 1) * 4096, wv, lane);
        nsa_tile_step<4, true, false>(st, qa, Kb + (j & 1) * 4096, Vb + (j & 1) * 4096, Pw, lane, j, pos0, mask64, nmaxv, mb2, invl);
    }
#pragma unroll
    for (int mi = 0; mi < 2; ++mi) { float lsum = st.lp[mi]; lsum += __shfl_xor(lsum, 16); lsum += __shfl_xor(lsum, 32); invl[mi] = lsum > 0.f ? 1.f / lsum : 0.f; }
    __syncthreads();
    nsa_issue_tile(kcmp, 64, vcmpT, 256, Kb, Vb, wv, lane);
    for (int j = 0; j < ncmp_tiles; ++j) {
        asm volatile("s_waitcnt vmcnt(0)" ::: "memory");
        __syncthreads();
        if (j + 1 < ncmp_tiles) nsa_issue_tile(kcmp + (size_t)(j + 1) * 64 * 64, 64, vcmpT + (j + 1) * 64, 256, Kb + ((j + 1) & 1) * 4096, Vb + ((j + 1) & 1) * 4096, wv, lane);
        nsa_tile_step<4, false, true>(st, qa, Kb + (j & 1) * 4096, Vb + (j & 1) * 4096, Pw, lane, j, pos0, mask64, nmaxv, mb2, invl);
        __syncthreads();
        {
            const int tl = tid & 31, part = tid >> 5;
            for (int jj = part; jj <= 16; jj += 8) {
                const int jsel = j * 16 + jj;
                if (jsel < 64) {
                    int n_lo, n_hi;
                    if (jj == 16) { n_lo = 63; n_hi = 63; } else { n_lo = (jj == 0) ? 0 : 4 * jj - 1; n_hi = 4 * jj + 3; }
                    float acc = 0.f;
                    for (int gg = 0; gg < 4; ++gg)
                        for (int n = n_lo; n <= n_hi; ++n) acc += bf2f(Pall[gg * 2304 + tl * 72 + n]);
                    impf[tl * 64 + jsel] += acc;
                }
            }
        }
    }
    nsa_emit<true, true>(st, gates, mix, tok0, kvh, g, 0, lane);
    __syncthreads();
    for (int tt = 0; tt < 8; ++tt) {
        const int tl = g * 8 + tt;
        const int jb = lane;
        float v = impf[tl * 64 + jb];
        const bool causal = jb <= cur;
        const bool forced = (jb == 0) || (jb == cur) || (jb == cur - 1);
        v = causal ? (forced ? 1e4f : v) : NEGF;
        int rank = 0;
        for (int o = 0; o < 64; ++o) {
            const float vo = __shfl(v, o);
            rank += (vo > v || (vo == v && o < jb)) ? 1 : 0;
        }
        const unsigned long long mk = __ballot(rank < 16);
        if (lane == 0) mask64[tl] = mk;
    }
    __syncthreads();
    unsigned long long uni = 0ull;
    for (int i = 0; i < 32; ++i) uni |= mask64[i];
    uni &= (cur == 63) ? ~0ull : ((1ull << (cur + 1)) - 1ull);
    {
        const bf16_t* ks = (const bf16_t*)(ws + WS_KS) + (size_t)b * S_ * 128 + kvh * 64;
        const bf16_t* vsT = (const bf16_t*)(ws + WS_VST) + (size_t)(b * 2 + kvh) * 64 * S_;
        flash_reset(st);
        mb2[0] = qn2[0] * kmax_sel; mb2[1] = qn2[1] * kmax_sel;
        unsigned long long rem = uni;
        int j = __builtin_ctzll(rem); rem &= rem - 1ull;
        nsa_issue_tile(ks + (size_t)j * 64 * 128, 128, vsT + j * 64, S_, Kb, Vb, wv, lane);
        int bufi = 0;
        for (;;) {
            asm volatile("s_waitcnt vmcnt(0)" ::: "memory");
            __syncthreads();
            const bool more = rem != 0ull;
            int jn = 0;
            if (more) { jn = __builtin_ctzll(rem); rem &= rem - 1ull;
                nsa_issue_tile(ks + (size_t)jn * 64 * 128, 128, vsT + jn * 64, S_, Kb + (bufi ^ 1) * 4096, Vb + (bufi ^ 1) * 4096, wv, lane); }
            if (j == cur) nsa_tile_step<2, false, false>(st, qa, Kb + bufi * 4096, Vb + bufi * 4096, Pw, lane, j, pos0, mask64, nmaxv, mb2, invl);
            else          nsa_tile_step<1, false, false>(st, qa, Kb + bufi * 4096, Vb + bufi * 4096, Pw, lane, j, pos0, mask64, nmaxv, mb2, invl);
            if (!more) break;
            j = jn; bufi ^= 1;
        }
        nsa_emit<false, false>(st, gates, mix, tok0, kvh, g, 1, lane);
    }
    {
        const bf16_t* kw = (const bf16_t*)(ws + WS_KW) + (size_t)b * S_ * 128 + kvh * 64;
        const bf16_t* vwT = (const bf16_t*)(ws + WS_VWT) + (size_t)(b * 2 + kvh) * 64 * S_;
        flash_reset(st);
        mb2[0] = qn2[0] * kmax_win; mb2[1] = qn2[1] * kmax_win;
        const int j0 = (cur >= 8 ? cur - 8 : 0);
        __syncthreads();
        nsa_issue_tile(kw + (size_t)j0 * 64 * 128, 128, vwT + j0 * 64, S_, Kb, Vb, wv, lane);
        for (int j = j0; j <= cur; ++j) {
            const int bi = (j - j0) & 1;
            asm volatile("s_waitcnt vmcnt(0)" ::: "memory");
            __syncthreads();
            if (j + 1 <= cur) nsa_issue_tile(kw + (size_t)(j + 1) * 64 * 128, 128, vwT + (j + 1) * 64, S_, Kb + (bi ^ 1) * 4096, Vb + (bi ^ 1) * 4096, wv, lane);
            if (j == cur)           nsa_tile_step<2, false, false>(st, qa, Kb + bi * 4096, Vb + bi * 4096, Pw, lane, j, pos0, mask64, nmaxv, mb2, invl);
            else if (j == cur - 8)  nsa_tile_step<3, false, false>(st, qa, Kb + bi * 4096, Vb + bi * 4096, Pw, lane, j, pos0, mask64, nmaxv, mb2, invl);
            else                    nsa_tile_step<0, false, false>(st, qa, Kb + bi * 4096, Vb + bi * 4096, Pw, lane, j, pos0, mask64, nmaxv, mb2, invl);
        }
        nsa_emit<false, false>(st, gates, mix, tok0, kvh, g, 2, lane);
    }
    __syncthreads();
}

__device__ __forceinline__ void xattn_item(const Params& p, int l, int item, char* smem) {
    const int tid = launder(threadIdx.x), lane = tid & 63, w = __builtin_amdgcn_readfirstlane(tid >> 6), lc = lane & 15, lq = lane >> 4;
    char* ws = launder_p(p.ws);
    const int h = item & 3, qt = item >> 2;
    const int tok0 = qt * 64 + w * 16, b = (qt * 64) / S_;
    const bf16_t* qx = (const bf16_t*)(ws + WS_QXA);
    const bf16_t* km = (const bf16_t*)(ws + WS_KMEM) + (size_t)l * (NB * 4 * 256 * 256) + (size_t)(b * 4 + h) * 256 * 256;
    const bf16_t* vmT = (const bf16_t*)(ws + WS_VMEMT) + (size_t)l * (NB * 4 * 256 * 256) + (size_t)(b * 4 + h) * 256 * 256;
    bf16_t* oxa = (bf16_t*)(ws + WS_MIX);
    bf16_t* Kt = (bf16_t*)smem;
    bf16_t* Vt = Kt + 64 * 256;
    constexpr float C2 = 0.0625f * 1.4426950408889634f;
    bf16x8 qa[8];
#pragma unroll
    for (int kk = 0; kk < 8; ++kk) qa[kk] = *(const bf16x8*)(qx + (size_t)(tok0 + lc) * DM + h * 256 + kk * 32 + lq * 8);
    float ss = 0.f;
#pragma unroll
    for (int kk = 0; kk < 8; ++kk)
#pragma unroll
        for (int e = 0; e < 8; ++e) { const float f = bf2f((bf16_t)qa[kk][e]); ss += f * f; }
    ss += __shfl_xor(ss, 16); ss += __shfl_xor(ss, 32);
    const float kmax = 2.f * sqrtf(__uint_as_float(__hip_atomic_load((const unsigned*)(ws + WS_KNMAX) + l * 4, __ATOMIC_RELAXED, __HIP_MEMORY_SCOPE_AGENT)));
    const float mb2 = sqrtf(ss) * C2 * kmax;
    f32x4 o[16];
#pragma unroll
    for (int nd = 0; nd < 16; ++nd) o[nd] = (f32x4){0.f, 0.f, 0.f, 0.f};
    float lp = 0.f;
    for (int j = 0; j < 4; ++j) {
        __syncthreads();
        {
            const int krow_in = lane >> 5, kpos = lane & 31, vrow_in = lane >> 3, vpos = lane & 7;
#pragma unroll
            for (int i = 0; i < 8; ++i) {
                const int pc = w * 8 + i;
                const int krow = pc * 2 + krow_in;
                glds16(km + (size_t)(j * 64 + krow) * 256 + ((kpos ^ (krow & 15)) << 3), Kt + pc * 512);
                const int vrow = pc * 8 + vrow_in;
                glds16(vmT + (size_t)vrow * 256 + j * 64 + ((vpos ^ vrow_in) << 3), Vt + pc * 512);
            }
        }
        asm volatile("s_waitcnt vmcnt(0)" ::: "memory");
        __syncthreads();
        float pv[4][4];
#pragma unroll
        for (int ni = 0; ni < 4; ++ni) {
            f32x4 s = (f32x4){0.f, 0.f, 0.f, 0.f};
            const int row = ni * 16 + lc;
#pragma unroll
            for (int kk = 0; kk < 8; ++kk) {
                const bf16x8 kb = *(const bf16x8*)(Kt + row * 256 + (((kk * 4 + lq) ^ (row & 15)) << 3));
                s = mfma16(kb, qa[kk], s);
            }
#pragma unroll
            for (int r = 0; r < 4; ++r) { pv[ni][r] = __builtin_amdgcn_exp2f(fmaf(s[r], C2, -mb2)); lp += pv[ni][r]; }
        }
        bf16x8 pb[2];
#pragma unroll
        for (int sx = 0; sx < 2; ++sx) {
            const uint4 pk = make_uint4(pack2(pv[2 * sx][0], pv[2 * sx][1]), pack2(pv[2 * sx][2], pv[2 * sx][3]),
                                        pack2(pv[2 * sx + 1][0], pv[2 * sx + 1][1]), pack2(pv[2 * sx + 1][2], pv[2 * sx + 1][3]));
            pb[sx] = __builtin_bit_cast(bf16x8, pk);
        }
#pragma unroll
        for (int nd = 0; nd < 16; ++nd) {
            const int row = nd * 16 + lc;
#pragma unroll
            for (int sx = 0; sx < 2; ++sx) {
                const int c0 = 4 * sx + (lq >> 1), c1 = c0 + 2;
                const uint2 lo = *(const uint2*)(Vt + row * 64 + ((c0 ^ (lc & 7)) << 3) + (lq & 1) * 4);
                const uint2 hi = *(const uint2*)(Vt + row * 64 + ((c1 ^ (lc & 7)) << 3) + (lq & 1) * 4);
                o[nd] = mfma16(__builtin_bit_cast(bf16x8, make_uint4(lo.x, lo.y, hi.x, hi.y)), pb[sx], o[nd]);
            }
        }
    }
    lp += __shfl_xor(lp, 16); lp += __shfl_xor(lp, 32);
    const float linv = 1.f / lp;
#pragma unroll
    for (int nd = 0; nd < 16; ++nd)
        *(uint2*)(oxa + (size_t)(tok0 + lc) * DM + h * 256 + nd * 16 + lq * 4) = make_uint2(pack2(o[nd][0] * linv, o[nd][1] * linv), pack2(o[nd][2] * linv, o[nd][3] * linv));
}

__device__ __forceinline__ void peer_hn_rows(const Params& p, int l) {
    const int tid = launder(threadIdx.x), lane = tid & 63, w = tid >> 6;
    char* ws = launder_p(p.ws);
    const bf16_t* xbr = (const bf16_t*)(ws + WS_XB);
    const float* sumsq2 = (const float*)(ws + WS_SUMSQ) + (size_t)(l * 2 + 1) * T_ * 16;
    const float* gf = p.in[22] + l * 1024;
    unsigned char* hnb = (unsigned char*)(ws + WS_HN);
    for (int t = blockIdx.x * 4 + w; t < T_; t += gridDim.x * 4) {
        const float rs = rstd_from_parts(sumsq2, t);
        float hn[16];
        const uint4 x0 = *(const uint4*)(xbr + (size_t)t * DM + lane * 16), x1 = *(const uint4*)(xbr + (size_t)t * DM + lane * 16 + 8);
        const unsigned xw[8] = {x0.x, x0.y, x0.z, x0.w, x1.x, x1.y, x1.z, x1.w};
#pragma unroll
        for (int i = 0; i < 4; ++i) {
            const float4 gg = *(const float4*)(gf + lane * 16 + i * 4);
            hn[i * 4] = __uint_as_float(xw[2 * i] << 16) * rs * gg.x; hn[i * 4 + 1] = __uint_as_float(xw[2 * i] & 0xFFFF0000u) * rs * gg.y;
            hn[i * 4 + 2] = __uint_as_float(xw[2 * i + 1] << 16) * rs * gg.z; hn[i * 4 + 3] = __uint_as_float(xw[2 * i + 1] & 0xFFFF0000u) * rs * gg.w;
        }
        int o[4];
#pragma unroll
        for (int i = 0; i < 4; ++i) {
            int wd = 0;
            wd = __builtin_amdgcn_cvt_pk_fp8_f32(hn[4 * i], hn[4 * i + 1], wd, false);
            wd = __builtin_amdgcn_cvt_pk_fp8_f32(hn[4 * i + 2], hn[4 * i + 3], wd, true);
            o[i] = wd;
        }
        *(uint4*)(hnb + (size_t)t * DM + lane * 16) = make_uint4((unsigned)o[0], (unsigned)o[1], (unsigned)o[2], (unsigned)o[3]);
    }
}

typedef _Float16 h2_t __attribute__((ext_vector_type(2)));
template<int CTRL> __device__ __forceinline__ h2_t dpph(h2_t v) { return __builtin_bit_cast(h2_t, __builtin_amdgcn_update_dpp(0, __builtin_bit_cast(int, v), CTRL, 0xF, 0xF, true)); }
__device__ __forceinline__ float dot2bf(unsigned a, unsigned b, float c) {
    return __builtin_amdgcn_fdot2_f32_bf16(__builtin_bit_cast(bf16x2_t, a), __builtin_bit_cast(bf16x2_t, b), c, false);
}

typedef int i32x8_t __attribute__((ext_vector_type(8)));
constexpr int U_TB = 16;
constexpr int U_LISTCAP = U_TB * 128;

__device__ __forceinline__ void peer_u_phase(const Params& p, int l, char* smem) {
    const int tid = launder(threadIdx.x), lane = tid & 63, w = __builtin_amdgcn_readfirstlane(tid >> 6), n16 = lane & 15, kb = lane >> 4;
    char* ws = launder_p(p.ws);
    const unsigned char* u4 = (const unsigned char*)(ws + WS_UB) + (size_t)l * 16384 * 512;
    const unsigned char* hn8 = (const unsigned char*)(ws + WS_HN);
    const unsigned* eid2 = (const unsigned*)(ws + WS_EID);
    const float* gate = (const float*)(ws + WS_GATE);
    float* wgt = (float*)(ws + WS_ACT);
    unsigned* list = (unsigned*)(smem + w * (U_LISTCAP * 8));
    float* glist = (float*)(list + U_LISTCAP);
    const int G8 = (gridDim.x >= 8) ? 8 : 1;
    const int x = blockIdx.x % G8, bidx = blockIdx.x / G8, nbl = (gridDim.x - x + G8 - 1) / G8;
    const int nsl = 8 / G8;
    const int nbatch = T_ / U_TB;
    const int bsrc = 4 * (4 * n16 + kb);
    for (int r = 0; r < nsl; ++r) {
        const unsigned sl = (unsigned)(x * nsl + r);
        for (int bt = bidx * 4 + w; bt < nbatch; bt += nbl * 4) {
            const int t0 = bt * U_TB;
            uint4 A[16];
            {
                const unsigned char* hr = hn8 + (size_t)(t0 + (lane >> 2)) * DM + (lane & 3) * 16;
#pragma unroll
                for (int s = 0; s < 8; ++s) { A[2 * s] = *(const uint4*)(hr + s * 128); A[2 * s + 1] = *(const uint4*)(hr + s * 128 + 64); }
#pragma unroll
                for (int s = 0; s < 16; ++s) {
                    A[s].x = (unsigned)__builtin_amdgcn_ds_bpermute(bsrc, (int)A[s].x); A[s].y = (unsigned)__builtin_amdgcn_ds_bpermute(bsrc, (int)A[s].y);
                    A[s].z = (unsigned)__builtin_amdgcn_ds_bpermute(bsrc, (int)A[s].z); A[s].w = (unsigned)__builtin_amdgcn_ds_bpermute(bsrc, (int)A[s].w);
                }
            }
            int n = 0;
#pragma unroll 1
            for (int c = 0; c < U_TB; c += 4) {
                unsigned ids2[4]; float2 gt2[4];
#pragma unroll
                for (int i = 0; i < 4; ++i) { ids2[i] = eid2[(size_t)(t0 + c + i) * 64 + lane]; gt2[i] = *(const float2*)(gate + (size_t)(t0 + c + i) * 128 + 2 * lane); }
#pragma unroll
                for (int i = 0; i < 4; ++i) {
                    const unsigned id0 = ids2[i] & 0xFFFFu, id1 = ids2[i] >> 16;
                    const bool m0 = (id0 >> 11) == sl, m1 = (id1 >> 11) == sl;
                    const unsigned long long b0 = __ballot(m0), b1 = __ballot(m1);
                    const int n0 = __popcll(b0);
                    const int pos0 = n + __builtin_amdgcn_mbcnt_hi((unsigned)(b0 >> 32), __builtin_amdgcn_mbcnt_lo((unsigned)b0, 0u));
                    const int pos1 = n + n0 + __builtin_amdgcn_mbcnt_hi((unsigned)(b1 >> 32), __builtin_amdgcn_mbcnt_lo((unsigned)b1, 0u));
                    if (m0) { list[pos0] = ((unsigned)(c + i) << 24) | ((unsigned)(2 * lane) << 16) | id0; glist[pos0] = gt2[i].x; }
                    if (m1) { list[pos1] = ((unsigned)(c + i) << 24) | ((unsigned)(2 * lane + 1) << 16) | id1; glist[pos1] = gt2[i].y; }
                    n += n0 + __popcll(b1);
                }
            }
            if (n == 0) continue;
            const int ng = (n + 15) >> 4;
  \

#define U_FETCH(UB, EB, GB, g_) do { const int ei_ = (g_) * 16 + n16, ec_ = ei_ < n ? ei_ : 0; EB = list[ec_]; GB = glist[ec_]; \
        const int er_ = (g_) * 16 + (lane >> 2); const unsigned ER_ = list[er_ < n ? er_ : 0]; \
        const unsigned char* ur_ = u4 + (size_t)(ER_ & 0xFFFFu) * 512 + (lane & 3) * 16; \
        _Pragma("unroll") for (int s = 0; s < 8; ++s) UB[s] = *(const uint4*)(ur_ + s * 64); __builtin_amdgcn_sched_barrier(0); } while (0)
#define U_MATH(UB, EB, GB, g_) do { f32x4 acc_ = (f32x4){0.f, 0.f, 0.f, 0.f}; \
        _Pragma("unroll") for (int s = 0; s < 8; ++s) { \
            const i32x8_t av_ = {(int)A[2 * s].x, (int)A[2 * s].y, (int)A[2 * s].z, (int)A[2 * s].w, (int)A[2 * s + 1].x, (int)A[2 * s + 1].y, (int)A[2 * s + 1].z, (int)A[2 * s + 1].w}; \
            const i32x8_t bv_ = {__builtin_amdgcn_ds_bpermute(bsrc, (int)UB[s].x), __builtin_amdgcn_ds_bpermute(bsrc, (int)UB[s].y), \
                                 __builtin_amdgcn_ds_bpermute(bsrc, (int)UB[s].z), __builtin_amdgcn_ds_bpermute(bsrc, (int)UB[s].w), 0, 0, 0, 0}; \
            acc_ = __builtin_amdgcn_mfma_scale_f32_16x16x128_f8f6f4(av_, bv_, acc_, 0, 4, 0, 0, 0, 0); } \
        const int ei_ = (g_) * 16 + n16; const int tk_ = (int)((EB >> 16) & 0xFFu), ti_ = (int)(EB >> 24), rs_ = ti_ & 3; \
        const float d_ = rs_ == 0 ? acc_[0] : (rs_ == 1 ? acc_[1] : (rs_ == 2 ? acc_[2] : acc_[3])); \
        if (ei_ < n && (ti_ >> 2) == kb) glist[ei_] = GB * gelu_tanh(d_ * (1.f / U_SCALE)); } while (0)
            uint4 u0[8], u1[8], u2[8]; unsigned e0 = 0u, e1 = 0u, e2 = 0u; float g0 = 0.f, g1 = 0.f, g2 = 0.f;
            U_FETCH(u0, e0, g0, 0); U_FETCH(u1, e1, g1, 1);
            for (int g = 0; g < ng; g += 3) {
                U_FETCH(u2, e2, g2, g + 2);
                U_MATH(u0, e0, g0, g);
                if (g + 1 >= ng) break;
                U_FETCH(u0, e0, g0, g + 3);
                U_MATH(u1, e1, g1, g + 1);
                if (g + 2 >= ng) break;
                U_FETCH(u1, e1, g1, g + 4);
                U_MATH(u2, e2, g2, g + 2);
            }
#undef U_FETCH
#undef U_MATH
            for (int i = lane; i < n; i += 64) { const unsigned e = list[i]; wgt[(size_t)(t0 + (int)(e >> 24)) * 128 + (int)((e >> 16) & 0xFFu)] = glist[i] * 16.f; }
        }
    }
}

typedef short v4i16_t __attribute__((ext_vector_type(4)));
__device__ __forceinline__ uint2 lds_tr16(const char* p) {
    const v4i16_t t = __builtin_amdgcn_ds_read_tr16_b64_v4i16((__attribute__((address_space(3))) v4i16_t*)p);
    return __builtin_bit_cast(uint2, t);
}
__device__ __forceinline__ unsigned pack4_fp8(float4 v) {
    int wd = 0;
    wd = __builtin_amdgcn_cvt_pk_fp8_f32(v.x, v.y, wd, false);
    wd = __builtin_amdgcn_cvt_pk_fp8_f32(v.z, v.w, wd, true);
    return (unsigned)wd;
}
constexpr float W_SCALE = 16.f;

__device__ __forceinline__ void peer_v_phase(const Params& p, int l, char* smem) {
    const int tid = launder(threadIdx.x), lane = tid & 63, w = __builtin_amdgcn_readfirstlane(tid >> 6), n16 = lane & 15, kb = lane >> 4;
    char* ws = launder_p(p.ws);
    const unsigned char* v4 = (const unsigned char*)(ws + WS_VB) + (size_t)l * 16384 * 512;
    const unsigned* eid2 = (const unsigned*)(ws + WS_EID);
    const float* wgt = (const float*)(ws + WS_ACT);
    bf16_t* xb = (bf16_t*)(ws + WS_XB);
    float* parts = (float*)(ws + WS_PARTS0);
    char* buf = smem + w * 16384;
    const int G8 = (gridDim.x >= 8) ? 8 : 1;
    const int x = blockIdx.x % G8, bidx = blockIdx.x / G8, nbl = (gridDim.x - x + G8 - 1) / G8;
    const int nsl = 8 / G8;
    const int sh = 8 * (n16 & 3);
    const unsigned rmask = n16 < 4 ? 0xFFFFFFFFu : 0u;
    const int trofs = kb * 1024 + (n16 >> 2) * 128 + 8 * (n16 & 3);
    const unsigned trbase = (unsigned)(size_t)(__attribute__((address_space(3))) char*)(buf) + (unsigned)trofs;
    const int idsrc = 4 * (lane >> 4);
    const bool idhi = ((lane >> 3) & 1) != 0;
    for (int r = 0; r < nsl; ++r) {
        const int xs = x * nsl + r, cs = xs & 3, tend = ((xs >> 2) + 1) * (T_ / 2), step = nbl * 4;
        int t = (xs >> 2) * (T_ / 2) + bidx * 4 + w;
        if (t >= tend) continue;
        const unsigned char* vsl = v4 + cs * 128 + (lane & 7) * 16;
#define V_GATHER(IDW, eb_) do { _Pragma("unroll") for (int i_ = 0; i_ < 4; ++i_) { \
            const unsigned idp_ = (unsigned)__builtin_amdgcn_ds_bpermute(idsrc + 16 * (4 * (eb_) + i_), (int)(IDW)); \
            const unsigned id_ = idhi ? (idp_ >> 16) : (idp_ & 0xFFFFu); \
            glds16(vsl + (size_t)id_ * 512, buf + (4 * (eb_) + i_) * 1024); } } while (0)
        typedef float f32x4v __attribute__((ext_vector_type(4)));
        typedef unsigned u32x2v __attribute__((ext_vector_type(2)));
        const unsigned idw = eid2[(size_t)t * 64 + lane];
        const int t1 = (t + step < tend) ? t + step : t;
        unsigned idnx = eid2[(size_t)t1 * 64 + lane];
        f32x4v W0, W1, W2, W3, W4, W5, W6, W7;
        {
            const float* wp = wgt + (size_t)t * 128 + 4 * kb;
            W0 = *(const f32x4v*)(wp); W1 = *(const f32x4v*)(wp + 16); W2 = *(const f32x4v*)(wp + 32); W3 = *(const f32x4v*)(wp + 48);
            W4 = *(const f32x4v*)(wp + 64); W5 = *(const f32x4v*)(wp + 80); W6 = *(const f32x4v*)(wp + 96); W7 = *(const f32x4v*)(wp + 112);
        }
        u32x2v X0, X1, X2, X3;
        {
            const bf16_t* xp = xb + (size_t)t * DM + cs * 256 + 4 * n16;
            X0 = *(const u32x2v*)(xp); X1 = *(const u32x2v*)(xp + 64); X2 = *(const u32x2v*)(xp + 128); X3 = *(const u32x2v*)(xp + 192);
        }
        V_GATHER(idw, 0); V_GATHER(idw, 1); V_GATHER(idw, 2); V_GATHER(idw, 3);
        asm volatile("s_waitcnt vmcnt(0)" ::: "memory");
        for (; t < tend; t += step) {
            unsigned A[4][8];
            {
                const unsigned xa[8] = {pack4_fp8(make_float4(W0.x, W0.y, W0.z, W0.w)) & rmask, pack4_fp8(make_float4(W1.x, W1.y, W1.z, W1.w)) & rmask,
                                        pack4_fp8(make_float4(W2.x, W2.y, W2.z, W2.w)) & rmask, pack4_fp8(make_float4(W3.x, W3.y, W3.z, W3.w)) & rmask,
                                        pack4_fp8(make_float4(W4.x, W4.y, W4.z, W4.w)) & rmask, pack4_fp8(make_float4(W5.x, W5.y, W5.z, W5.w)) & rmask,
                                        pack4_fp8(make_float4(W6.x, W6.y, W6.z, W6.w)) & rmask, pack4_fp8(make_float4(W7.x, W7.y, W7.z, W7.w)) & rmask};
#pragma unroll
                for (int eb = 0; eb < 4; ++eb)
#pragma unroll
                    for (int d = 0; d < 4; ++d) { A[eb][d] = ((xa[2 * eb] >> (8 * d)) & 0xFFu) << sh; A[eb][4 + d] = ((xa[2 * eb + 1] >> (8 * d)) & 0xFFu) << sh; }
            }
            const unsigned idn = idnx;
            const uint2 xin[4] = {make_uint2(X0.x, X0.y), make_uint2(X1.x, X1.y), make_uint2(X2.x, X2.y), make_uint2(X3.x, X3.y)};
            bf16_t* xr = xb + (size_t)t * DM + cs * 256 + 4 * n16;
            {
                const int tn = (t + step < tend) ? t + step : t, tnn = (tn + step < tend) ? tn + step : tn;
                const unsigned* ipn = eid2 + (size_t)tnn * 64 + lane;
                const float* wp = wgt + (size_t)tn * 128 + 4 * kb;
                const bf16_t* xp = xb + (size_t)tn * DM + cs * 256 + 4 * n16;
                asm volatile("global_load_dword %0, %13, off\n\t"
                             "global_load_dwordx4 %1, %14, off\n\tglobal_load_dwordx4 %2, %14, off offset:64\n\tglobal_load_dwordx4 %3, %14, off offset:128\n\tglobal_load_dwordx4 %4, %14, off offset:192\n\t"
                             "global_load_dwordx4 %5, %14, off offset:256\n\tglobal_load_dwordx4 %6, %14, off offset:320\n\tglobal_load_dwordx4 %7, %14, off offset:384\n\tglobal_load_dwordx4 %8, %14, off offset:448\n\t"
                             "global_load_dwordx2 %9, %15, off\n\tglobal_load_dwordx2 %10, %15, off offset:128\n\tglobal_load_dwordx2 %11, %15, off offset:256\n\tglobal_load_dwordx2 %12, %15, off offset:384"
                             : "=&v"(idnx), "=&v"(W0), "=&v"(W1), "=&v"(W2), "=&v"(W3), "=&v"(W4), "=&v"(W5), "=&v"(W6), "=&v"(W7), "=&v"(X0), "=&v"(X1), "=&v"(X2), "=&v"(X3)
                             : "v"(ipn), "v"(wp), "v"(xp) : "memory");
            }
            f32x4 acc[4];
#pragma unroll
            for (int cb = 0; cb < 4; ++cb) acc[cb] = (f32x4){0.f, 0.f, 0.f, 0.f};
#pragma unroll
            for (int eb = 0; eb < 4; ++eb) {
                asm volatile("s_waitcnt vmcnt(25)" ::: "memory");
                const i32x8_t av = {(int)A[eb][0], (int)A[eb][1], (int)A[eb][2], (int)A[eb][3], (int)A[eb][4], (int)A[eb][5], (int)A[eb][6], (int)A[eb][7]};
                unsigned long long q0, q1, q2, q3, q4, q5, q6, q7;
                const unsigned la = trbase + eb * 4096;
                asm volatile("ds_read_b64_tr_b16 %0, %8\n\tds_read_b64_tr_b16 %1, %8 offset:512\n\t"
                             "ds_read_b64_tr_b16 %2, %8 offset:32\n\tds_read_b64_tr_b16 %3, %8 offset:544\n\t"
                             "ds_read_b64_tr_b16 %4, %8 offset:64\n\tds_read_b64_tr_b16 %5, %8 offset:576\n\t"
                             "ds_read_b64_tr_b16 %6, %8 offset:96\n\tds_read_b64_tr_b16 %7, %8 offset:608\n\t"
                             "s_waitcnt lgkmcnt(0)"
                             : "=&v"(q0), "=&v"(q1), "=&v"(q2), "=&v"(q3), "=&v"(q4), "=&v"(q5), "=&v"(q6), "=&v"(q7) : "v"(la) : "memory");
                {
                    const i32x8_t bv0 = {(int)q0, (int)(q0 >> 32), (int)q1, (int)(q1 >> 32), 0, 0, 0, 0};
                    const i32x8_t bv1 = {(int)q2, (int)(q2 >> 32), (int)q3, (int)(q3 >> 32), 0, 0, 0, 0};
                    const i32x8_t bv2 = {(int)q4, (int)(q4 >> 32), (int)q5, (int)(q5 >> 32), 0, 0, 0, 0};
                    const i32x8_t bv3 = {(int)q6, (int)(q6 >> 32), (int)q7, (int)(q7 >> 32), 0, 0, 0, 0};
                    acc[0] = __builtin_amdgcn_mfma_scale_f32_16x16x128_f8f6f4(av, bv0, acc[0], 0, 4, 0, 0, 0, 0);
                    acc[1] = __builtin_amdgcn_mfma_scale_f32_16x16x128_f8f6f4(av, bv1, acc[1], 0, 4, 0, 0, 0, 0);
                    acc[2] = __builtin_amdgcn_mfma_scale_f32_16x16x128_f8f6f4(av, bv2, acc[2], 0, 4, 0, 0, 0, 0);
                    acc[3] = __builtin_amdgcn_mfma_scale_f32_16x16x128_f8f6f4(av, bv3, acc[3], 0, 4, 0, 0, 0, 0);
                }
                V_GATHER(idn, eb);
                __builtin_amdgcn_sched_barrier(0);
            }
#pragma unroll
            for (int cb = 0; cb < 4; ++cb) {
                constexpr float OS = 1.f / (W_SCALE * V_SCALE);
                const float xv0 = __uint_as_float(xin[cb].x << 16) + acc[cb][0] * OS, xv1 = __uint_as_float(xin[cb].x & 0xFFFF0000u) + acc[cb][1] * OS;
                const float xv2 = __uint_as_float(xin[cb].y << 16) + acc[cb][2] * OS, xv3 = __uint_as_float(xin[cb].y & 0xFFFF0000u) + acc[cb][3] * OS;
                const float ss = row16_sum(xv0 * xv0 + xv1 * xv1 + xv2 * xv2 + xv3 * xv3);
                if (kb == 0) *(uint2*)(xr + cb * 64) = make_uint2(pack2(xv0, xv1), pack2(xv2, xv3));
                if (lane == 0) parts[(size_t)t * 16 + cs * 4 + cb] = ss;
            }
            asm volatile("s_waitcnt vmcnt(16)" : "+v"(W0), "+v"(W1), "+v"(W2), "+v"(W3), "+v"(W4), "+v"(W5), "+v"(W6), "+v"(W7), "+v"(idnx), "+v"(X0), "+v"(X1), "+v"(X2), "+v"(X3) :: "memory");
        }
#undef V_GATHER
        asm volatile("s_waitcnt vmcnt(0)" ::: "memory");
    }
}

__device__ __forceinline__ void final_norm_phase(const Params& p) {
    const int tid = launder(threadIdx.x), lane = tid & 63, w = tid >> 6;
    char* ws = launder_p(p.ws);
    const bf16_t* xbr = (const bf16_t*)(ws + WS_XB);
    const float* parts = (const float*)(ws + WS_PARTS0);
    const float* fg = p.in[27];
    for (int t = blockIdx.x * 4 + w; t < T_; t += gridDim.x * 4) {
        const float rn = rstd_from_parts(parts, t);
#pragma unroll
        for (int i = 0; i < 2; ++i) {
            const uint4 a = *(const uint4*)(xbr + (size_t)t * DM + i * 512 + lane * 8);
            const float4 g0 = *(const float4*)(fg + i * 512 + lane * 8), g1 = *(const float4*)(fg + i * 512 + lane * 8 + 4);
            float* o = p.out + (size_t)t * DM + i * 512 + lane * 8;
            *(float4*)o = make_float4(__uint_as_float(a.x << 16) * rn * g0.x, __uint_as_float(a.x & 0xFFFF0000u) * rn * g0.y, __uint_as_float(a.y << 16) * rn * g0.z, __uint_as_float(a.y & 0xFFFF0000u) * rn * g0.w);
            *(float4*)(o + 4) = make_float4(__uint_as_float(a.z << 16) * rn * g1.x, __uint_as_float(a.z & 0xFFFF0000u) * rn * g1.y, __uint_as_float(a.w << 16) * rn * g1.z, __uint_as_float(a.w & 0xFFFF0000u) * rn * g1.w);
        }
    }
}

#define XB_TMO      128
#define XB_XCNT(j)  (256  + 64 * (j))
#define XB_XSUB(j)  (1280 + 64 * (j))
#define XB_XGEN(j)  (2304 + 64 * (j))
#define XB_TOP      3328
#define XB_TOPGEN   3392
#define XCD_BAR_WORDS 3456
#define XB_SPIN_CAP (1u << 22)
#define LAS __attribute__((address_space(3)))
__device__ __forceinline__ unsigned xb_ld(unsigned* p)              { return __hip_atomic_load(p, __ATOMIC_RELAXED, __HIP_MEMORY_SCOPE_AGENT); }
__device__ __forceinline__ unsigned xb_add(unsigned* p, unsigned v) { return __hip_atomic_fetch_add(p, v, __ATOMIC_RELAXED, __HIP_MEMORY_SCOPE_AGENT); }
__device__ __forceinline__ unsigned xb_xcc_id() { return (unsigned)__builtin_amdgcn_s_getreg((3 << 11) | 20) & 0xFu; }
#define XB_SPIN(cond, bar) do { unsigned _sp = 0; while (cond) { __builtin_amdgcn_s_sleep(1); \
    if ((++_sp & 255u) == 0u) { if (xb_ld(&(bar)[XB_TMO])) break; if (_sp > XB_SPIN_CAP) { atomicAdd(&(bar)[XB_TMO], 1u); break; } } } } while (0)
struct XcdBarrier { unsigned* bar; unsigned x; volatile LAS unsigned* st; };
__device__ __forceinline__ XcdBarrier xcd_barrier_post(unsigned* bar, volatile LAS unsigned* st) {
    XcdBarrier b; b.bar = bar; b.x = xb_xcc_id(); b.st = st;
    if (threadIdx.x == 0) (void)xb_add(&bar[XB_XCNT(b.x)], 1u);
    return b;
}
__device__ __forceinline__ void xcd_barrier_complete(unsigned* bar, unsigned x, unsigned& nloc, unsigned& nx) {
    const unsigned G = gridDim.x * gridDim.y * gridDim.z;
    unsigned sum, cnt, mine, sp = 0u;
    for (;;) {
        sum = 0u; cnt = 0u; mine = 0u;
#pragma unroll
        for (unsigned j = 0; j < 16; ++j) { const unsigned c = xb_ld(&bar[XB_XCNT(j)]); sum += c; cnt += (c > 0u) ? 1u : 0u; mine = (j == x) ? c : mine; }
        if (sum == G) break;
        __builtin_amdgcn_s_sleep(1);
        if ((++sp & 255u) == 0u) { if (xb_ld(&bar[XB_TMO])) break; if (sp > XB_SPIN_CAP) { atomicAdd(&bar[XB_TMO], 1u); break; } }
    }
    nloc = mine > 0u ? mine : 1u; nx = cnt > 0u ? cnt : 1u;
}
__device__ __forceinline__ void xcd_barrier(const XcdBarrier& b) {
    asm volatile("s_waitcnt vmcnt(0)" ::: "memory");
    __syncthreads();
    if (threadIdx.x == 0) {
        unsigned* bar = b.bar;
        __builtin_amdgcn_s_waitcnt(0);
        unsigned nloc = b.st[0], nx = b.st[1];
        if (nloc == 0u) { xcd_barrier_complete(bar, b.x, nloc, nx); b.st[0] = nloc; b.st[1] = nx; }
        const unsigned old = xb_add(&bar[XB_XSUB(b.x)], 1u);
        const unsigned gen = old / nloc;
        if (old + 1u == (gen + 1u) * nloc) {
            __builtin_amdgcn_fence(__ATOMIC_RELEASE, "agent");
            asm volatile("s_waitcnt vmcnt(0)" ::: "memory");
            const unsigned og = xb_add(&bar[XB_TOP], 1u);
            const unsigned tg = og / nx;
            if (og + 1u == (tg + 1u) * nx) xb_add(&bar[XB_TOPGEN], 1u);
            else XB_SPIN(xb_ld(&bar[XB_TOPGEN]) == tg, bar);
            __builtin_amdgcn_fence(__ATOMIC_ACQUIRE, "agent");
            xb_add(&bar[XB_XGEN(b.x)], 1u);
            asm volatile("s_waitcnt vmcnt(0)" ::: "memory");
        } else {
            XB_SPIN(xb_ld(&bar[XB_XGEN(b.x)]) == gen, bar);
            __builtin_amdgcn_fence(__ATOMIC_ACQUIRE, "agent");
            asm volatile("s_waitcnt vmcnt(0)" ::: "memory");
        }
    }
    __syncthreads();
}


__device__ __forceinline__ bool xcd_tile(int i, int bid, int G, int nM, int nN, int& tm, int& tn) {
    if ((G & 7) != 0 || (nM & 7) != 0) { const int it = bid + i * G; if (it >= nM * nN) return false; tm = it / nN; tn = it % nN; return true; }
    const int x = bid & 7, lt = (bid >> 3) + i * (G >> 3), pm = nM >> 3;
    if (lt >= pm * nN) return false;
    tm = x * pm + lt / nN; tn = lt % nN; return true;
}

constexpr int PH_PER_LAYER = 11;
constexpr int N_PHASES = 1 + 2 * PH_PER_LAYER + 1;

__device__ __forceinline__ void run_phase(const Params& p, int ph, char* smem) {
    char* ws = launder_p(p.ws);
    const int G = gridDim.x, bid = blockIdx.x;
    if (ph == 0) { phase_prep(p, smem); return; }
    if (ph == N_PHASES - 1) { final_norm_phase(p); return; }
    const int l = (ph - 1) / PH_PER_LAYER, sp = (ph - 1) % PH_PER_LAYER;
    char* W = ws + WS_W + l * W_STRIDE;
    float* sumsq1 = (float*)(ws + WS_SUMSQ) + (size_t)(l * 2 + 0) * T_ * 16;
    float* sumsq2 = (float*)(ws + WS_SUMSQ) + (size_t)(l * 2 + 1) * T_ * 16;
    switch (sp) {
    case 0: {
        EpiWin e{(const float*)(ws + WS_PARTS0), (const float*)(ws + WS_ROPE), (bf16_t*)(ws + WS_Q), (bf16_t*)(ws + WS_KC), (bf16_t*)(ws + WS_VC), (bf16_t*)(ws + WS_KS),
                 (bf16_t*)(ws + WS_KW), (bf16_t*)(ws + WS_VST), (bf16_t*)(ws + WS_VWT), (bf16_t*)(ws + WS_GLU), (bf16_t*)(ws + WS_ZP), (float*)(ws + WS_GATES), (unsigned*)(ws + WS_KNMAX) + l * 4};
        ALin al{(const bf16_t*)(ws + WS_XB), DM};
        if (bid == G - 1) {
            const int t_ = launder(threadIdx.x);
            for (int o = t_; o < 512; o += NTHREADS) {
                const float* pp = (const float*)(ws + WS_CBPART) + (size_t)(l * 2 + (o >> 8)) * 32 * 256 + (o & 255);
                float s = 0.f;
                for (int c = 0; c < 32; ++c) s += pp[c * 256];
                ((float*)(W + W_CBIAS))[o] = s;
            }
        }
        const int extra = (l == 0) ? 2 * 8 * 16 : 0;
        int li = bid, nlight = G;
        if ((G & 7) == 0) { const int per = G >> 3, rem = (16 * 17) % per; if (rem != 0) { li = ((bid >> 3) - rem) * 8 + (bid & 7); nlight = (per - rem) * 8; } }
        else { const int rem = (128 * 17) % G; if (rem != 0) { li = bid - rem; nlight = G - rem; } }
        { int tm, tn;
          for (int i = 0; xcd_tile(i, bid, G, 128, 17, tm, tn); ++i) {
                if (tn == 7 || tn == 9) gemm_tile<false>(al, (const bf16_t*)(W + W_WIN), DM, NWIN, DM, tm * 128, tn * 128, e, smem);
                else gemm_tile<true>(al, (const bf16_t*)(W + W_WIN), DM, NWIN, DM, tm * 128, tn * 128, e, smem);
          } }
        if (l == 0) conv_weights(p, 0, 4, smem);
        if (l == 1 && li >= 0) {
            const int cgt = li * NTHREADS + launder(threadIdx.x), cgs = nlight * NTHREADS;
            conv_fp4<false>(p.in[25] + (size_t)l * 16384 * 1024, (unsigned char*)(ws + WS_UB) + (size_t)l * 16384 * 512, (size_t)16384 * 1024, U_SCALE, cgt, cgs);
            conv_fp4<false>(p.in[26] + (size_t)l * 16384 * 1024, (unsigned char*)(ws + WS_VB) + (size_t)l * 16384 * 512, (size_t)16384 * 1024, V_SCALE, cgt, cgs);
        }
        for (int it = li; it >= 0 && it < extra; it += nlight) {
            {
                const int j = it, ll = j >> 7, r = j & 127, tn = r & 15, tm = r >> 4;
                ALin am{(const bf16_t*)(ws + WS_MEMB), DM};
                EpiMemKV em{(const float*)(ws + WS_RSTDM), (bf16_t*)(ws + WS_KMEM) + (size_t)ll * (NB * 4 * 256 * 256), (bf16_t*)(ws + WS_VMEMT) + (size_t)ll * (NB * 4 * 256 * 256), (unsigned*)(ws + WS_KNMAX) + ll * 4};
                if (tn >= 8) gemm_tile<false>(am, (const bf16_t*)(ws + WS_W + ll * W_STRIDE + W_XWKV), DM, 2048, DM, tm * 128, tn * 128, em, smem);
                else gemm_tile<true>(am, (const bf16_t*)(ws + WS_W + ll * W_STRIDE + W_XWKV), DM, 2048, DM, tm * 128, tn * 128, em, smem);
            }
        }
    } break;
    case 1: {
        const int ncmp = 2 * 16 * 2 * 4;
        for (int it = bid; it < ncmp + 1024; it += G) {
            if (it < ncmp) {
                const int ks = it & 3, r0 = it >> 2, kv = r0 >> 5, r = r0 & 31, tn = r & 1, tm = r >> 1;
                ACmp ac{(const bf16_t*)(ws + (kv == 0 ? WS_KC : WS_VC)), ks * 512};
                EpiCmp1 e{(float*)(ws + WS_CPART) + ((size_t)(ks * 2 + kv)) * 2048 * 256};
                gemm_tile<true>(ac, (const bf16_t*)(W + W_CW1) + (size_t)kv * 256 * 2048 + ks * 512, 2048, 256, 512, tm * 128, tn * 128, e, smem);
            } else {
                convpool_tile(p, l, it - ncmp, smem);
            }
        }
    } break;
    case 2: {
        for (int it = bid; it < 32; it += G) {
            const int kv = it >> 4, tm = it & 15;
            {
                const int t_ = launder(threadIdx.x);
                const float* cpart = (const float*)(ws + WS_CPART);
                const float* bias = (const float*)(W + W_CBIAS) + kv * 256;
                bf16_t* hid = (bf16_t*)(ws + WS_HID) + (size_t)kv * 2048 * 256;
                for (int u = t_; u < 128 * 32; u += NTHREADS) {
                    const int row = tm * 128 + (u >> 5), c0 = (u & 31) * 8;
                    float v[8];
                    { const float4 b0 = *(const float4*)(bias + c0), b1 = *(const float4*)(bias + c0 + 4); v[0] = b0.x; v[1] = b0.y; v[2] = b0.z; v[3] = b0.w; v[4] = b1.x; v[5] = b1.y; v[6] = b1.z; v[7] = b1.w; }
#pragma unroll
                    for (int ks = 0; ks < 4; ++ks) {
                        const float* s = cpart + ((size_t)(ks * 2 + kv) * 2048 + row) * 256 + c0;
                        const float4 a0 = *(const float4*)s, a1 = *(const float4*)(s + 4);
                        v[0] += a0.x; v[1] += a0.y; v[2] += a0.z; v[3] += a0.w; v[4] += a1.x; v[5] += a1.y; v[6] += a1.z; v[7] += a1.w;
                    }
#pragma unroll
                    for (int e = 0; e < 8; ++e) v[e] = gelu_tanh(v[e]);
                    *(uint4*)(hid + (size_t)row * 256 + c0) = pack8(v);
                }
                asm volatile("s_waitcnt vmcnt(0)" ::: "memory");
                __threadfence();
                __syncthreads();
            }
            ALin al{(const bf16_t*)(ws + WS_HID) + (size_t)kv * 2048 * 256, 256};
            EpiCmp2 e{kv, (bf16_t*)(ws + WS_KCMP), (bf16_t*)(ws + WS_VCMPT), (unsigned*)(ws + WS_KNMAX) + l * 4};
            if (kv == 0) gemm_tile<true>(al, (const bf16_t*)(W + W_CW2) + (size_t)kv * 64 * 256, 256, 64, 256, tm * 128, 0, e, smem);
            else gemm_tile<false>(al, (const bf16_t*)(W + W_CW2) + (size_t)kv * 64 * 256, 256, 64, 256, tm * 128, 0, e, smem);
        }
    } break;
    case 3: {
        const int cgt = bid * NTHREADS + launder(threadIdx.x), cgs = G * NTHREADS;
        if (l == 0 && (bid & 1)) {
            conv_fp4<false>(p.in[25] + (size_t)l * 16384 * 1024, (unsigned char*)(ws + WS_UB) + (size_t)l * 16384 * 512, (size_t)16384 * 1024, U_SCALE, cgt, cgs);
            conv_fp4<false>(p.in[26] + (size_t)l * 16384 * 1024, (unsigned char*)(ws + WS_VB) + (size_t)l * 16384 * 512, (size_t)16384 * 1024, V_SCALE, cgt, cgs);
        }
        for (int r = 0; r * G < 1024; ++r) { const int it = (r & 1) ? (r + 1) * G - 1 - bid : r * G + bid; if (it < 1024) nsa_item(p, l, it, smem); }
        if (l == 0) conv_weights(p, 1, 1 | 4 | 8, smem);
        if (l == 0 && !(bid & 1)) {
            conv_fp4<false>(p.in[25] + (size_t)l * 16384 * 1024, (unsigned char*)(ws + WS_UB) + (size_t)l * 16384 * 512, (size_t)16384 * 1024, U_SCALE, cgt, cgs);
            conv_fp4<false>(p.in[26] + (size_t)l * 16384 * 1024, (unsigned char*)(ws + WS_VB) + (size_t)l * 16384 * 512, (size_t)16384 * 1024, V_SCALE, cgt, cgs);
        }
    } break;
    case 4: {
        EpiRes e{(bf16_t*)(ws + WS_XB), sumsq1};
        ALin al{(const bf16_t*)(ws + WS_MIX), DM};
        { int tm, tn; for (int i = 0; xcd_tile(i, bid, G, 128, 8, tm, tn); ++i) gemm_tile<true>(al, (const bf16_t*)(W + W_WOUT), DM, DM, DM, tm * 128, tn * 128, e, smem); }
    } break;
    case 5: {
        EpiScale e{sumsq1, (bf16_t*)(ws + WS_QXA), DM};
        ALin al{(const bf16_t*)(ws + WS_XB), DM};
        { int tm, tn; for (int i = 0; xcd_tile(i, bid, G, 128, 8, tm, tn); ++i) gemm_tile<true>(al, (const bf16_t*)(W + W_XWQ), DM, DM, DM, tm * 128, tn * 128, e, smem); }
    } break;
    case 6: {
        for (int it = bid; it < 1024; it += G) xattn_item(p, l, it, smem);
    } break;
    case 7: {
        EpiRes e{(bf16_t*)(ws + WS_XB), sumsq2};
        ALin al{(const bf16_t*)(ws + WS_MIX), DM};
        { int tm, tn; for (int i = 0; xcd_tile(i, bid, G, 128, 8, tm, tn); ++i) gemm_tile<true>(al, (const bf16_t*)(W + W_XWO), DM, DM, DM, tm * 128, tn * 128, e, smem); }
    } break;
    case 8: {
        EpiPeerQ e{sumsq2, (const bf16_t*)(W + W_SUBK), (unsigned short*)(ws + WS_EID), (float*)(ws + WS_GATE), smem};
        ALin al{(const bf16_t*)(ws + WS_XB), DM};
        { int tm, hh; for (int i = 0; xcd_tile(i, bid, G, 128, 8, tm, hh); ++i) {
            gemm_tile<true>(al, (const bf16_t*)(W + W_PWQ), DM, 2048, DM, tm * 128, (2 * hh) * 128, e, smem);
            gemm_tile<true>(al, (const bf16_t*)(W + W_PWQ), DM, 2048, DM, tm * 128, (2 * hh + 1) * 128, e, smem); } }
        peer_hn_rows(p, l);
    } break;
    case 9: peer_u_phase(p, l, smem); break;
    case 10: peer_v_phase(p, l, smem); break;
    }
}

__global__ void __launch_bounds__(NTHREADS, 2) mega_kernel(Params p) {
    extern __shared__ __attribute__((aligned(16))) char smem[];
    volatile LAS unsigned* bst = (volatile LAS unsigned*)(smem + LDS_PHASE_BYTES);
    XcdBarrier xb; xb.bar = (unsigned*)(p.ws + WS_CTL); xb.x = 0; xb.st = bst;
    if (p.ph_hi - p.ph_lo > 1) {
        if (threadIdx.x < 4) bst[threadIdx.x] = 0u;
        __syncthreads();
        xb = xcd_barrier_post((unsigned*)(p.ws + WS_CTL), bst);
    }
    for (int ph = p.ph_lo; ph < p.ph_hi; ++ph) {
        run_phase(p, ph, smem);
        if (ph + 1 < p.ph_hi) {
            if (ph == p.ph_lo) cg::this_grid().sync();
            else xcd_barrier(xb);
        }
    }
}

extern "C" void kernel_launch(void* const* d_in, const int* in_sizes, int n_in, void* d_out, int out_size, void* d_ws, size_t ws_size, hipStream_t stream) {
    static int grid = 0;
    if (grid == 0) {
        if (n_in != 28 || ws_size < WS_END) { fprintf(stderr, "kernel_launch: unexpected inputs (%d) or workspace (%zu < %zu)\n", n_in, ws_size, (size_t)WS_END); grid = -1; return; }
        int dev = 0, cus = 0, per_cu = 0;
        hipGetDevice(&dev);
        hipDeviceGetAttribute(&cus, hipDeviceAttributeMultiprocessorCount, dev);
        hipFuncSetAttribute((const void*)mega_kernel, hipFuncAttributeMaxDynamicSharedMemorySize, LDS_BYTES);
        hipOccupancyMaxActiveBlocksPerMultiprocessor(&per_cu, (const void*)mega_kernel, NTHREADS, LDS_BYTES);
        if (per_cu < 1) { fprintf(stderr, "kernel_launch: occupancy query returned %d\n", per_cu); grid = -1; return; }
        if (per_cu > 2) per_cu = 2;
        grid = cus * per_cu;
    }
    if (grid < 0) return;
    Params p{};
    for (int i = 0; i < 28; ++i) p.in[i] = (const float*)d_in[i];
    p.out = (float*)d_out; p.ws = (char*)d_ws;
    for (int i = 0; i < 8; ++i) p.freq[i] = pow(500000.0, -(double)i / 8.0);
#if SINGLE_LAUNCH
    (void)hipMemsetAsync((char*)d_ws + WS_CTL, 0, XCD_BAR_WORDS * 4, stream);
    p.ph_lo = 0; p.ph_hi = N_PHASES;
    void* args[] = {&p};
    hipError_t e = hipLaunchCooperativeKernel((const void*)mega_kernel, dim3(grid), dim3(NTHREADS), args, LDS_BYTES, stream);
    if (e != hipSuccess) fprintf(stderr, "cooperative launch failed: %s (grid %d)\n", hipGetErrorString(e), grid);
#else
    for (int ph = 0; ph < N_PHASES; ++ph) {
        p.ph_lo = ph; p.ph_hi = ph + 1;
        hipLaunchKernelGGL(mega_kernel, dim3(grid), dim3(NTHREADS), LDS_BYTES, stream, p);
#ifdef REPEAT_LIST
        { const int rl[] = {REPEAT_LIST}; for (int r : rl) if (r == ph) hipLaunchKernelGGL(mega_kernel, dim3(grid), dim3(NTHREADS), LDS_BYTES, stream, p); }
#endif
    }
#endif
}

#ifdef PHASE_PROBE
template <int PH> __global__ void __launch_bounds__(NTHREADS, 2) probe_kernel(Params p) {
    extern __shared__ __attribute__((aligned(16))) char smem[];
    run_phase(p, PH, smem);
}
#ifdef ONLY_PH
template __global__ void probe_kernel<ONLY_PH>(Params);
#else
template __global__ void probe_kernel<0>(Params);
template __global__ void probe_kernel<1>(Params);
template __global__ void probe_kernel<2>(Params);
template __global__ void probe_kernel<3>(Params);
template __global__ void probe_kernel<4>(Params);
template __global__ void probe_kernel<5>(Params);
template __global__ void probe_kernel<6>(Params);
template __global__ void probe_kernel<7>(Params);
template __global__ void probe_kernel<8>(Params);
template __global__ void probe_kernel<9>(Params);
template __global__ void probe_kernel<10>(Params);
template __global__ void probe_kernel<11>(Params);
#endif
#endif
```

```cpp
#include <hip/hip_runtime.h>
#include <hip/hip_cooperative_groups.h>
#include <cstdio>
#include <cstdint>
#include <cmath>
namespace cg = cooperative_groups;

#ifndef SINGLE_LAUNCH
#define SINGLE_LAUNCH 1
#endif

typedef unsigned short bf16_t;
typedef short bf16x8 __attribute__((ext_vector_type(8)));
typedef float f32x4 __attribute__((ext_vector_type(4)));
typedef __bf16 bf16x2_t __attribute__((ext_vector_type(2)));

constexpr int NB = 4, S_ = 4096, T_ = NB * S_, DM = 1024;
constexpr int NWIN = 2176;
constexpr int NCMP = 255;
constexpr float EPS = 1e-6f;
constexpr float NEGF = -1e30f;
constexpr int LDS_PHASE_BYTES = 72 * 1024;
constexpr int LDS_BYTES = LDS_PHASE_BYTES + 64;
constexpr int NTHREADS = 256;

constexpr size_t MB = 1024 * 1024;
constexpr size_t WS_CTL    = 0;
constexpr size_t WS_KNMAX  = 32 * 1024;
constexpr size_t WS_CBPART = 1 * MB;
constexpr size_t WS_SUMSQ  = 2 * MB;
constexpr size_t WS_PARTS0 = WS_SUMSQ + 4 * T_ * 16 * 4;
constexpr size_t WS_RSTDM  = WS_PARTS0 + (size_t)T_ * 16 * 4;
constexpr size_t WS_ROPE   = WS_RSTDM + 4096;
constexpr size_t WS_GATES  = WS_ROPE + (size_t)T_ * 16 * 4;
constexpr size_t WS_MEMB   = WS_GATES + (size_t)T_ * 24 * 4;
constexpr size_t WS_KMEM   = WS_MEMB + 2 * MB;
constexpr size_t WS_VMEMT  = WS_KMEM + 4 * MB;
constexpr size_t WS_KCMP   = WS_VMEMT + 4 * MB;
constexpr size_t WS_VCMPT  = WS_KCMP + 256 * 1024;
constexpr size_t WS_HID    = WS_VCMPT + 256 * 1024;
constexpr size_t WS_W      = WS_HID + 2 * MB;
constexpr size_t W_WIN   = 0;
constexpr size_t W_WOUT  = W_WIN + (size_t)NWIN * 1024 * 2;
constexpr size_t W_XWQ   = W_WOUT + 2 * MB;
constexpr size_t W_XWKV  = W_XWQ + 2 * MB;
constexpr size_t W_XWO   = W_XWKV + 4 * MB;
constexpr size_t W_PWQ   = W_XWO + 2 * MB;
constexpr size_t W_CW1   = W_PWQ + 4 * MB;
constexpr size_t W_CW2   = W_CW1 + 2 * MB;
constexpr size_t W_CBIAS = W_CW2 + 64 * 1024;
constexpr size_t W_PW    = W_CBIAS + 4096;
constexpr size_t W_POOLW = W_PW + 128 * 1024;
constexpr size_t W_SUBK  = W_POOLW + 32 * 1024;
constexpr size_t W_STRIDE = W_SUBK + 64 * 1024;
constexpr size_t WS_UB     = WS_W + 2 * W_STRIDE;
constexpr size_t WS_VB     = WS_UB + 64 * MB;
constexpr size_t WS_XRES   = WS_VB + 64 * MB;
constexpr size_t WS_XB     = WS_XRES + 64 * MB;
constexpr size_t WS_NSA    = WS_XB + 32 * MB;
constexpr size_t WS_Q      = WS_NSA;
constexpr size_t WS_KC     = WS_Q + 16 * MB;
constexpr size_t WS_KS     = WS_KC + 4 * MB;
constexpr size_t WS_KW     = WS_KS + 4 * MB;
constexpr size_t WS_VC     = WS_KW + 4 * MB;
constexpr size_t WS_VST    = WS_VC + 4 * MB;
constexpr size_t WS_VWT    = WS_VST + 4 * MB;
constexpr size_t WS_GLU    = WS_VWT + 4 * MB;
constexpr size_t WS_ZP     = WS_GLU + 8 * MB;
constexpr size_t WS_PQ     = WS_NSA;
constexpr size_t WS_MIX    = WS_NSA + 64 * MB;
constexpr size_t WS_QXA    = WS_MIX + 32 * MB;
constexpr size_t WS_TOPK   = WS_QXA + 32 * MB;
constexpr size_t WS_CPART  = WS_TOPK;
constexpr size_t WS_EID    = WS_TOPK + 16 * MB;
constexpr size_t WS_GATE   = WS_EID + 4 * MB;
constexpr size_t WS_ACT    = WS_GATE + 8 * MB;
constexpr size_t WS_HN     = WS_QXA;
constexpr size_t WS_END    = WS_ACT + 8 * MB;

struct Params {
    const float* in[28];
    float* out;
    char* ws;
    double freq[8];
    int ph_lo, ph_hi;
};

__device__ __forceinline__ float bf2f(bf16_t b) { return __uint_as_float(((unsigned)b) << 16); }
typedef float f32x2_t __attribute__((ext_vector_type(2)));
__device__ __forceinline__ bf16_t f2bf(float f) { __bf16 h = (__bf16)f; return __builtin_bit_cast(bf16_t, h); }
__device__ __forceinline__ unsigned pack2(float a, float b) { f32x2_t v = {a, b}; bf16x2_t h = __builtin_convertvector(v, bf16x2_t); return __builtin_bit_cast(unsigned, h); }
template <int CTRL> __device__ __forceinline__ float dppf(float v) { return __builtin_bit_cast(float, __builtin_amdgcn_update_dpp(0, __builtin_bit_cast(int, v), CTRL, 0xf, 0xf, false)); }
__device__ __forceinline__ float row16_sum(float v) { v += dppf<0xB1>(v); v += dppf<0x4E>(v); v += dppf<0x141>(v); v += dppf<0x140>(v); return v; }
__device__ __forceinline__ float row16_max(float v) { v = fmaxf(v, dppf<0xB1>(v)); v = fmaxf(v, dppf<0x4E>(v)); v = fmaxf(v, dppf<0x141>(v)); v = fmaxf(v, dppf<0x140>(v)); return v; }
__device__ __forceinline__ float sigmoidf_(float x) { return 1.f / (1.f + __expf(-x)); }
__device__ __forceinline__ float gelu_tanh(float x) {
    const float y = 0.7978845608028654f * (x + 0.044715f * x * x * x);
    const float e = __expf(2.f * y);
    const float t = 1.f - 2.f / (e + 1.f);
    return 0.5f * x * (1.f + t);
}
__device__ __forceinline__ float wave_sum(float v) {
#pragma unroll
    for (int o = 32; o >= 1; o >>= 1) v += __shfl_xor(v, o);
    return v;
}
__device__ __forceinline__ f32x4 mfma16(bf16x8 a, bf16x8 b, f32x4 c) { return __builtin_amdgcn_mfma_f32_16x16x32_bf16(a, b, c, 0, 0, 0); }
__device__ __forceinline__ float rstd_from_parts(const float* __restrict__ parts, int row) {
    const float4 a = *(const float4*)(parts + (size_t)row * 16), b = *(const float4*)(parts + (size_t)row * 16 + 4);
    const float4 c = *(const float4*)(parts + (size_t)row * 16 + 8), d = *(const float4*)(parts + (size_t)row * 16 + 12);
    const float s = ((a.x + a.y) + (a.z + a.w)) + ((b.x + b.y) + (b.z + b.w)) + ((c.x + c.y) + (c.z + c.w)) + ((d.x + d.y) + (d.z + d.w));
    return rsqrtf(s * (1.f / DM) + EPS);
}
__device__ __forceinline__ unsigned f2key(float f) { unsigned u = __float_as_uint(f); return u ^ ((unsigned)((int)u >> 31) | 0x80000000u); }
__device__ __forceinline__ float key2f(unsigned k) { k &= ~127u; unsigned u = (k & 0x80000000u) ? (k ^ 0x80000000u) : ~k; return __uint_as_float(u); }

__device__ __forceinline__ int launder(int v) { asm volatile("" : "+v"(v)); return v; }
__device__ __forceinline__ char* launder_p(char* q) { long z = 0; asm volatile("" : "+s"(z)); return q + z; }
__device__ __forceinline__ int swzr(int r) { return ((r >> 1) & 1) | ((((r >> 2) ^ (r >> 4)) & 1) << 1) | (((r >> 3) & 1) << 2); }
__device__ __forceinline__ int swz64(int row, int chunk) { return row * 64 + ((chunk ^ swzr(row)) << 3); }

struct ALin { const bf16_t* A; int lda;
    __device__ __forceinline__ const bf16_t* ptr(int row, int k) const { return A + (size_t)row * lda + k; }
    __device__ __forceinline__ const bf16_t* adv(const bf16_t* p0, int kt) const { return p0 + kt * 64; } };
struct ACmp { const bf16_t* src; int koff;
    __device__ __forceinline__ const bf16_t* ptr(int row, int k_) const {
        const int k = k_ + koff;
        const int r = row < 2040 ? row : 2039; const int kvh = r & 1, bn = r >> 1, b = bn / NCMP, n = bn - b * NCMP;
        return src + ((size_t)(b * S_ + 16 * n + (k >> 6)) * 128 + kvh * 64 + (k & 63)); }
    __device__ __forceinline__ const bf16_t* adv(const bf16_t* p0, int kt) const { return p0 + kt * 128; } };

typedef __attribute__((address_space(3))) unsigned lds_u32_t;
typedef __attribute__((address_space(1))) const unsigned glb_u32_t;
__device__ __forceinline__ void glds16(const void* gsrc, void* ldst) {
    __builtin_amdgcn_global_load_lds((glb_u32_t*)gsrc, (lds_u32_t*)ldst, 16, 0, 0);
}

template <bool SWAP, class AL, class EPI>
__device__ __forceinline__ void gemm_tile(const AL& al, const bf16_t* __restrict__ Bt, int ldb, int nB, int K, int m0, int n0, const EPI& epi, char* smem,
                                          int pre = 0, int nm0 = 0, int nn0 = 0) {
    const int tid = launder(threadIdx.x), lane = tid & 63, w = __builtin_amdgcn_readfirstlane(tid >> 6), wr = w >> 1, wc = w & 1;
    bf16_t* As = (bf16_t*)smem;
    bf16_t* Bs = As + 2 * 8192;
    f32x4 acc[4][4];
#pragma unroll
    for (int i = 0; i < 4; ++i)
#pragma unroll
        for (int j = 0; j < 4; ++j) acc[i][j] = (f32x4){0.f, 0.f, 0.f, 0.f};
    const int nk = K >> 6;
    const int row_in = lane >> 3;
    const bf16_t* ga[4]; const bf16_t* gb[4];
#pragma unroll
    for (int i = 0; i < 4; ++i) {
        const int row = (w * 4 + i) * 8 + row_in;
        const int gch = ((lane & 7) ^ swzr(row)) * 8;
        ga[i] = al.ptr(m0 + row, gch);
        int br = n0 + row; br = br < nB ? br : nB - 1;
        gb[i] = Bt + (size_t)br * ldb + gch;
    }
    if (!(pre & 1)) {
#pragma unroll
        for (int i = 0; i < 4; ++i) {
            glds16(ga[i], As + (w * 4 + i) * 512);
            glds16(gb[i], Bs + (w * 4 + i) * 512);
        }
    }
    asm volatile("s_waitcnt vmcnt(0)" ::: "memory");
    __syncthreads();
    for (int kt = 0; kt < nk; ++kt) {
        const int buf = kt & 1;
        if (kt + 1 < nk) {
#pragma unroll
            for (int i = 0; i < 4; ++i) {
                glds16(al.adv(ga[i], kt + 1), As + (buf ^ 1) * 8192 + (w * 4 + i) * 512);
                glds16(gb[i] + (kt + 1) * 64, Bs + (buf ^ 1) * 8192 + (w * 4 + i) * 512);
            }
        }
        const bf16_t* Ab = As + buf * 8192;
        const bf16_t* Bb = Bs + buf * 8192;
#pragma unroll
        for (int kk = 0; kk < 2; ++kk) {
            bf16x8 a[4], b[4];
            const int ch = kk * 4 + (lane >> 4);
#pragma unroll
            for (int mi = 0; mi < 4; ++mi) a[mi] = *(const bf16x8*)(Ab + swz64(wr * 64 + mi * 16 + (lane & 15), ch));
#pragma unroll
            for (int ni = 0; ni < 4; ++ni) {
                const int brow = SWAP ? ((ni >> 1) * 32 + ((lane & 15) >> 2) * 8 + (ni & 1) * 4 + (lane & 3)) : (ni * 16 + (lane & 15));
                b[ni] = *(const bf16x8*)(Bb + swz64(wc * 64 + brow, ch));
            }
            __builtin_amdgcn_s_setprio(1);
#pragma unroll
            for (int mi = 0; mi < 4; ++mi)
#pragma unroll
                for (int ni = 0; ni < 4; ++ni) acc[mi][ni] = SWAP ? mfma16(b[ni], a[mi], acc[mi][ni]) : mfma16(a[mi], b[ni], acc[mi][ni]);
            __builtin_amdgcn_s_setprio(0);
        }
        asm volatile("s_waitcnt vmcnt(0)" ::: "memory");
        __syncthreads();
    }
    if (pre & 2) {
#pragma unroll
        for (int i = 0; i < 4; ++i) {
            const int row = (w * 4 + i) * 8 + row_in;
            const int gch = ((lane & 7) ^ swzr(row)) * 8;
            int br = nn0 + row; br = br < nB ? br : nB - 1;
            glds16(al.ptr(nm0 + row, gch), As + (w * 4 + i) * 512);
            glds16(Bt + (size_t)br * ldb + gch, Bs + (w * 4 + i) * 512);
        }
    }
    if (SWAP) epi.swapped(acc, m0 + wr * 64, n0 + wc * 64, lane); else epi(acc, m0 + wr * 64, n0 + wc * 64, lane);
}

#define ACC8(acc, mi, p, v) float v[8] = {acc[mi][2 * (p)][0], acc[mi][2 * (p)][1], acc[mi][2 * (p)][2], acc[mi][2 * (p)][3], acc[mi][2 * (p) + 1][0], acc[mi][2 * (p) + 1][1], acc[mi][2 * (p) + 1][2], acc[mi][2 * (p) + 1][3]}
__device__ __forceinline__ uint4 pack8(const float (&v)[8]) { uint4 o; o.x = pack2(v[0], v[1]); o.y = pack2(v[2], v[3]); o.z = pack2(v[4], v[5]); o.w = pack2(v[6], v[7]); return o; }

struct EpiWin {
    const float* rstd; const float* rope; bf16_t *q, *kc, *vc, *ks, *kw, *vsT, *vwT, *glu, *zp; float* gates; unsigned* knmax;
    __device__ __forceinline__ void operator()(f32x4 (&acc)[4][4], int mb, int nb, int lane) const {
        const int lc = lane & 15, lq = lane >> 4;
        const int sec = ((nb - 512) >> 7) + 1;
        bf16_t* dst = sec == 4 ? vsT : vwT;
#pragma unroll
        for (int mi = 0; mi < 4; ++mi) {
            const int row0 = mb + mi * 16 + lq * 4;
            float rs[4];
#pragma unroll
            for (int r = 0; r < 4; ++r) rs[r] = rstd_from_parts(rstd, row0 + r);
            const int b = row0 / S_, t = row0 % S_;
#pragma unroll
            for (int ni = 0; ni < 4; ++ni) {
                const int cs = nb + ni * 16 + lc - (512 + (sec - 1) * 128);
                const int kvh = cs >> 6, d = cs & 63;
                uint2 pk; pk.x = pack2(acc[mi][ni][0] * rs[0], acc[mi][ni][1] * rs[1]); pk.y = pack2(acc[mi][ni][2] * rs[2], acc[mi][ni][3] * rs[3]);
                *(uint2*)(dst + (size_t)((b * 2 + kvh) * 64 + d) * S_ + t) = pk;
            }
        }
    }
    __device__ __forceinline__ void swapped(f32x4 (&acc)[4][4], int mb, int nb, int lane) const {
        const int lc = lane & 15, lq = lane >> 4;
        float kmx = 0.f;
        const bool is_q = nb < 512;
        const int sec = is_q ? 0 : ((nb - 512) >> 7) + 1;
        const bool rope_sec = nb < 1280 && (is_q || sec == 1 || sec == 3 || sec == 5);
        const bool knorm = nb < 1280 && (sec == 3 || sec == 5);
#pragma unroll
        for (int mi = 0; mi < 4; ++mi) {
            const int row = mb + mi * 16 + lc;
            const float rs = rstd_from_parts(rstd, row);
            float rowss = 0.f;
#pragma unroll
            for (int p = 0; p < 2; ++p) {
                ACC8(acc, mi, p, v);
#pragma unroll
                for (int e = 0; e < 8; ++e) v[e] *= rs;
                const int c0 = nb + p * 32 + lq * 8;
                if (nb < 1280) {
                    if (rope_sec && p == 0) {
                        float o[8];
#pragma unroll
                        for (int e = 0; e < 8; ++e) o[e] = __shfl_xor(v[e], 16);
                        if (lq < 2) {
                            const float4 r0 = *(const float4*)(rope + (size_t)row * 16), r1 = *(const float4*)(rope + (size_t)row * 16 + 4);
                            const float4 r2 = *(const float4*)(rope + (size_t)row * 16 + 8), r3 = *(const float4*)(rope + (size_t)row * 16 + 12);
                            const float cs_[8] = {r0.x, r0.z, r1.x, r1.z, r2.x, r2.z, r3.x, r3.z}, sn_[8] = {r0.y, r0.w, r1.y, r1.w, r2.y, r2.w, r3.y, r3.w};
#pragma unroll
                            for (int e = 0; e < 8; ++e) v[e] = (lq == 0) ? (v[e] * cs_[e] - o[e] * sn_[e]) : (o[e] * sn_[e] + v[e] * cs_[e]);
                        }
                    }
                    if (knorm) {
#pragma unroll
                        for (int e = 0; e < 8; ++e) rowss += v[e] * v[e];
                    }
                    const uint4 pk = pack8(v);
                    if (is_q) *(uint4*)(q + (size_t)row * 512 + c0) = pk;
                    else {
                        bf16_t* dst = sec == 1 ? kc : (sec == 2 ? vc : (sec == 3 ? ks : kw));
                        *(uint4*)(dst + (size_t)row * 128 + (c0 - (512 + (sec - 1) * 128))) = pk;
                    }
                } else if (nb < 1792) {
                    const int gI = ((nb - 1280) >> 3) + p * 4 + lq;
                    uint2 pk; pk.x = pack2(v[0] * sigmoidf_(v[4]), v[1] * sigmoidf_(v[5])); pk.y = pack2(v[2] * sigmoidf_(v[6]), v[3] * sigmoidf_(v[7]));
                    *(uint2*)(glu + (size_t)row * 256 + gI * 4) = pk;
                } else if (nb < 2048) {
                    *(uint4*)(zp + (size_t)row * 256 + (c0 - 1792)) = pack8(v);
                } else {
                    const int g0 = c0 - 2048;
                    if (g0 < 24) {
                        *(float4*)(gates + (size_t)row * 24 + g0) = make_float4(sigmoidf_(v[0]), sigmoidf_(v[1]), sigmoidf_(v[2]), sigmoidf_(v[3]));
                        *(float4*)(gates + (size_t)row * 24 + g0 + 4) = make_float4(sigmoidf_(v[4]), sigmoidf_(v[5]), sigmoidf_(v[6]), sigmoidf_(v[7]));
                    }
                }
            }
            if (knorm) { rowss += __shfl_xor(rowss, 16); rowss += __shfl_xor(rowss, 32); kmx = fmaxf(kmx, rowss); }
        }
        if (knorm) {
            kmx = row16_max(kmx);
            if (lane == 0) atomicMax(&knmax[sec == 3 ? 1 : 2], __float_as_uint(kmx));
        }
    }
};

struct EpiRes {
    bf16_t* xb; float* sumsq;
    __device__ __forceinline__ void operator()(f32x4 (&acc)[4][4], int mb, int nb, int lane) const {}
    __device__ __forceinline__ void swapped(f32x4 (&acc)[4][4], int mb, int nb, int lane) const {
        const int lc = lane & 15, lq = lane >> 4;
#pragma unroll
        for (int mi = 0; mi < 4; ++mi) {
            const int row = mb + mi * 16 + lc;
            float ss = 0.f;
#pragma unroll
            for (int p = 0; p < 2; ++p) {
                ACC8(acc, mi, p, v);
                const size_t idx = (size_t)row * DM + nb + p * 32 + lq * 8;
                const uint4 r = *(const uint4*)(xb + idx);
                v[0] += __uint_as_float(r.x << 16); v[1] += __uint_as_float(r.x & 0xFFFF0000u); v[2] += __uint_as_float(r.y << 16); v[3] += __uint_as_float(r.y & 0xFFFF0000u);
                v[4] += __uint_as_float(r.z << 16); v[5] += __uint_as_float(r.z & 0xFFFF0000u); v[6] += __uint_as_float(r.w << 16); v[7] += __uint_as_float(r.w & 0xFFFF0000u);
                *(uint4*)(xb + idx) = pack8(v);
#pragma unroll
                for (int e = 0; e < 8; ++e) ss += v[e] * v[e];
            }
            ss += __shfl_xor(ss, 16); ss += __shfl_xor(ss, 32);
            if (lq == 0) sumsq[(size_t)row * 16 + (nb >> 6)] = ss;
        }
    }
};

struct EpiScale {
    const float* sumsq; bf16_t* out; int ldo;
    __device__ __forceinline__ void operator()(f32x4 (&acc)[4][4], int mb, int nb, int lane) const {}
    __device__ __forceinline__ void swapped(f32x4 (&acc)[4][4], int mb, int nb, int lane) const {
        const int lc = lane & 15, lq = lane >> 4;
#pragma unroll
        for (int mi = 0; mi < 4; ++mi) {
            const int row = mb + mi * 16 + lc;
            const float rs = rstd_from_parts(sumsq, row);
#pragma unroll
            for (int p = 0; p < 2; ++p) {
                ACC8(acc, mi, p, v);
#pragma unroll
                for (int e = 0; e < 8; ++e) v[e] *= rs;
                *(uint4*)(out + (size_t)row * ldo + nb + p * 32 + lq * 8) = pack8(v);
            }
        }
    }
};

struct EpiMemKV {
    const float* rstd; bf16_t* kmem; bf16_t* vmemT; unsigned* kq;
    __device__ __forceinline__ void operator()(f32x4 (&acc)[4][4], int mb, int nb, int lane) const {
        const int lc = lane & 15, lq = lane >> 4;
#pragma unroll
        for (int mi = 0; mi < 4; ++mi) {
            const int row0 = mb + mi * 16 + lq * 4, b = row0 >> 8, m = row0 & 255;
            float rs[4];
#pragma unroll
            for (int r = 0; r < 4; ++r) rs[r] = rstd[row0 + r];
#pragma unroll
            for (int ni = 0; ni < 4; ++ni) {
                const int c2 = nb + ni * 16 + lc - 1024, h = c2 >> 8, d = c2 & 255;
                uint2 pk; pk.x = pack2(acc[mi][ni][0] * rs[0], acc[mi][ni][1] * rs[1]); pk.y = pack2(acc[mi][ni][2] * rs[2], acc[mi][ni][3] * rs[3]);
                *(uint2*)(vmemT + ((size_t)((b * 4 + h) * 256 + d)) * 256 + m) = pk;
            }
        }
    }
    __device__ __forceinline__ void swapped(f32x4 (&acc)[4][4], int mb, int nb, int lane) const {
        const int lc = lane & 15, lq = lane >> 4;
        float kmx = 0.f;
#pragma unroll
        for (int mi = 0; mi < 4; ++mi) {
            const int row = mb + mi * 16 + lc, b = row >> 8, m = row & 255;
            const float rs = rstd[row];
            float ss = 0.f;
#pragma unroll
            for (int p = 0; p < 2; ++p) {
                ACC8(acc, mi, p, v);
#pragma unroll
                for (int e = 0; e < 8; ++e) { v[e] *= rs; ss += v[e] * v[e]; }
                const int c0 = nb + p * 32 + lq * 8, h = c0 >> 8, d = c0 & 255;
                *(uint4*)(kmem + ((size_t)((b * 4 + h) * 256 + m)) * 256 + d) = pack8(v);
            }
            ss += __shfl_xor(ss, 16); ss += __shfl_xor(ss, 32);
            kmx = fmaxf(kmx, ss);
        }
        kmx = row16_max(kmx);
        if (lane == 0) atomicMax(kq, __float_as_uint(kmx));
    }
};

struct EpiCmp1 {
    float* part;
    __device__ __forceinline__ void operator()(f32x4 (&acc)[4][4], int mb, int nb, int lane) const {}
    __device__ __forceinline__ void swapped(f32x4 (&acc)[4][4], int mb, int nb, int lane) const {
        const int lc = lane & 15, lq = lane >> 4;
#pragma unroll
        for (int mi = 0; mi < 4; ++mi)
#pragma unroll
            for (int p = 0; p < 2; ++p) {
                float* d = part + (size_t)(mb + mi * 16 + lc) * 256 + nb + p * 32 + lq * 8;
                *(float4*)d = make_float4(acc[mi][2 * p][0], acc[mi][2 * p][1], acc[mi][2 * p][2], acc[mi][2 * p][3]);
                *(float4*)(d + 4) = make_float4(acc[mi][2 * p + 1][0], acc[mi][2 * p + 1][1], acc[mi][2 * p + 1][2], acc[mi][2 * p + 1][3]);
            }
    }
};

struct EpiCmp2 {
    int kv; bf16_t* kcmp; bf16_t* vcmpT; unsigned* knmax;
    __device__ __forceinline__ void operator()(f32x4 (&acc)[4][4], int mb, int nb, int lane) const {
        const int lc = lane & 15, lq = lane >> 4;
#pragma unroll
        for (int mi = 0; mi < 4; ++mi)
#pragma unroll
            for (int ni = 0; ni < 4; ++ni) {
                const int d = nb + ni * 16 + lc;
                if (d < 64) {
#pragma unroll
                    for (int r = 0; r < 4; ++r) {
                        const int row = mb + mi * 16 + lq * 4 + r;
                        if (row < 2040) {
                            const int kvh = row & 1, bn = row >> 1, b = bn / NCMP, n = bn - b * NCMP;
                            vcmpT[((size_t)((b * 2 + kvh) * 64 + d)) * 256 + n] = f2bf(acc[mi][ni][r]);
                        }
                    }
                }
            }
    }
    __device__ __forceinline__ void swapped(f32x4 (&acc)[4][4], int mb, int nb, int lane) const {
        const int lc = lane & 15, lq = lane >> 4;
        if (nb != 0) return;
        float kmx = 0.f;
#pragma unroll
        for (int mi = 0; mi < 4; ++mi) {
            const int row = mb + mi * 16 + lc;
            const bool ok = row < 2040;
            const int kvh = row & 1, bn = row >> 1, b = bn / NCMP, n = bn - b * NCMP;
            float ss = 0.f;
#pragma unroll
            for (int p = 0; p < 2; ++p) {
                ACC8(acc, mi, p, v);
#pragma unroll
                for (int e = 0; e < 8; ++e) ss += v[e] * v[e];
                if (ok) *(uint4*)(kcmp + ((size_t)((b * 2 + kvh) * 256 + n)) * 64 + p * 32 + lq * 8) = pack8(v);
            }
            ss += __shfl_xor(ss, 16); ss += __shfl_xor(ss, 32);
            if (ok) kmx = fmaxf(kmx, ss);
        }
        kmx = row16_max(kmx);
        if (lane == 0) atomicMax(&knmax[3], __float_as_uint(kmx));
    }
};

__device__ __forceinline__ void sort16_desc(unsigned (&a)[16]) {
#pragma unroll
    for (int k = 2; k <= 16; k <<= 1)
#pragma unroll
        for (int j = k >> 1; j > 0; j >>= 1)
#pragma unroll
            for (int i = 0; i < 16; ++i) {
                const int l = i ^ j;
                if (l > i) {
                    const unsigned hi = max(a[i], a[l]), lo = min(a[i], a[l]);
                    if ((i & k) == 0) { a[i] = hi; a[l] = lo; } else { a[i] = lo; a[l] = hi; }
                }
            }
}
__device__ __forceinline__ void merge16_desc(unsigned (&a)[16], const unsigned (&b)[16]) {
#pragma unroll
    for (int i = 0; i < 16; ++i) a[i] = max(a[i], b[15 - i]);
#pragma unroll
    for (int j = 8; j > 0; j >>= 1)
#pragma unroll
        for (int i = 0; i < 16; ++i) {
            const int l = i ^ j;
            if (l > i) { const unsigned hi = max(a[i], a[l]), lo = min(a[i], a[l]); a[i] = hi; a[l] = lo; }
        }
}

struct EpiPeerQ {
    const float* sumsq; const bf16_t* subk; unsigned short* eid; float* gate; char* smem;
    __device__ __forceinline__ void operator()(f32x4 (&acc)[4][4], int mb, int nb, int lane) const {}
    __device__ __forceinline__ void swapped(f32x4 (&acc)[4][4], int mb, int nb, int lane) const {
        const int tid = launder(threadIdx.x), w = __builtin_amdgcn_readfirstlane(tid >> 6), wr = w >> 1, wc = w & 1, lc = lane & 15, lq = lane >> 4;
        const int m0 = mb - wr * 64, n0 = nb - wc * 64;
        const int hp = n0 >> 7, pp = hp & 1;
        bf16_t* As = (bf16_t*)smem;
        bf16_t* Bs = As + 2 * 8192;
        {
            const int row_in = lane >> 3;
#pragma unroll
            for (int kt = 0; kt < 2; ++kt)
#pragma unroll
                for (int i = 0; i < 4; ++i) {
                    const int row = (w * 4 + i) * 8 + row_in;
                    const int gch = ((lane & 7) ^ swzr(row)) * 8;
                    glds16(subk + (size_t)pp * 128 * 128 + (size_t)row * 128 + kt * 64 + gch, Bs + kt * 8192 + (w * 4 + i) * 512);
                }
        }
#pragma unroll
        for (int mi = 0; mi < 4; ++mi) {
            const int rl = wr * 64 + mi * 16 + lc;
            const float rs = rstd_from_parts(sumsq, m0 + rl);
#pragma unroll
            for (int p = 0; p < 2; ++p) {
                ACC8(acc, mi, p, v);
#pragma unroll
                for (int e = 0; e < 8; ++e) v[e] *= rs;
                const int chunk = p * 4 + lq;
                *(uint4*)(As + wc * 8192 + swz64(rl, chunk)) = pack8(v);
            }
        }
        asm volatile("s_waitcnt vmcnt(0)" ::: "memory");
        __syncthreads();
        f32x4 sc[4][4];
#pragma unroll
        for (int i = 0; i < 4; ++i)
#pragma unroll
            for (int j = 0; j < 4; ++j) sc[i][j] = (f32x4){0.f, 0.f, 0.f, 0.f};
#pragma unroll
        for (int kt = 0; kt < 2; ++kt)
#pragma unroll
            for (int kk = 0; kk < 2; ++kk) {
                bf16x8 a[4], b[4];
                const int ch = kk * 4 + lq;
#pragma unroll
                for (int mi = 0; mi < 4; ++mi) a[mi] = *(const bf16x8*)(As + kt * 8192 + swz64(wr * 64 + mi * 16 + lc, ch));
#pragma unroll
                for (int ni = 0; ni < 4; ++ni) b[ni] = *(const bf16x8*)(Bs + kt * 8192 + swz64(wc * 64 + ni * 16 + lc, ch));
#pragma unroll
                for (int mi = 0; mi < 4; ++mi)
#pragma unroll
                    for (int ni = 0; ni < 4; ++ni) sc[mi][ni] = mfma16(a[mi], b[ni], sc[mi][ni]);
            }
        __syncthreads();
        unsigned* S = (unsigned*)smem;
#pragma unroll
        for (int mi = 0; mi < 4; ++mi)
#pragma unroll
            for (int ni = 0; ni < 4; ++ni)
#pragma unroll
                for (int r = 0; r < 4; ++r) {
                    const int row = wr * 64 + mi * 16 + lq * 4 + r, col = wc * 64 + ni * 16 + lc;
                    S[row * 128 + (col ^ (row & 31))] = (f2key(sc[mi][ni][r]) & ~127u) | (unsigned)col;
                }
        __syncthreads();
        const int row = tid >> 1, half = tid & 1;
        unsigned top[16];
#pragma unroll
        for (int c = 0; c < 4; ++c) {
            unsigned ch[16];
#pragma unroll
            for (int i = 0; i < 16; ++i) ch[i] = S[row * 128 + ((half * 64 + c * 16 + i) ^ (row & 31))];
            sort16_desc(ch);
            if (c == 0) {
#pragma unroll
                for (int i = 0; i < 16; ++i) top[i] = ch[i];
            } else merge16_desc(top, ch);
        }
        {
            unsigned oth[16];
#pragma unroll
            for (int k = 0; k < 16; ++k) oth[k] = __shfl_xor(top[k], 1);
            merge16_desc(top, oth);
        }
        unsigned* T0 = (unsigned*)(smem + 65536) + row * 16;
        if (half == 0) {
            if (pp == 0) {
#pragma unroll
                for (int k4 = 0; k4 < 4; ++k4) *(uint4*)(T0 + k4 * 4) = make_uint4(top[k4 * 4], top[k4 * 4 + 1], top[k4 * 4 + 2], top[k4 * 4 + 3]);
            } else {
                constexpr unsigned char CI[50] = {0,0,0,0,0,0,0,0,0,0,0,0,0,0,0,0, 1,1,1,1,1,1,1,1, 2,2,2,2,2, 3,3,3,3, 4,4,4, 5,5, 6,6, 7,7, 8,9,10,11,12,13,14,15};
                constexpr unsigned char CJ[50] = {0,1,2,3,4,5,6,7,8,9,10,11,12,13,14,15, 0,1,2,3,4,5,6,7, 0,1,2,3,4, 0,1,2,3, 0,1,2, 0,1, 0,1, 0,1, 0,0,0,0,0,0,0,0};
                float va[16], vb[16]; unsigned ia[16], ib[16];
#pragma unroll
                for (int i4 = 0; i4 < 4; ++i4) {
                    const uint4 a = *(const uint4*)(T0 + i4 * 4);
                    va[i4 * 4] = key2f(a.x); va[i4 * 4 + 1] = key2f(a.y); va[i4 * 4 + 2] = key2f(a.z); va[i4 * 4 + 3] = key2f(a.w);
                    ia[i4 * 4] = (a.x & 127u) << 7; ia[i4 * 4 + 1] = (a.y & 127u) << 7; ia[i4 * 4 + 2] = (a.z & 127u) << 7; ia[i4 * 4 + 3] = (a.w & 127u) << 7;
                }
#pragma unroll
                for (int i = 0; i < 16; ++i) { vb[i] = key2f(top[i]); ib[i] = top[i] & 127u; }
                unsigned best[16];
#pragma unroll
                for (int cb = 0; cb < 4; ++cb) {
                    unsigned ch[16];
#pragma unroll
                    for (int i = 0; i < 16; ++i) {
                        const int c = cb * 16 + i;
                        ch[i] = (c < 50) ? ((f2key(va[CI[c < 50 ? c : 0]] + vb[CJ[c < 50 ? c : 0]]) & ~16383u) | ia[CI[c < 50 ? c : 0]] | ib[CJ[c < 50 ? c : 0]]) : 0u;
                    }
                    sort16_desc(ch);
                    if (cb == 0) {
#pragma unroll
                        for (int i = 0; i < 16; ++i) best[i] = ch[i];
                    } else merge16_desc(best, ch);
                }
                float e[16]; float dsum = 0.f;
                const unsigned k0 = best[0] & ~16383u;
                const float s0 = __uint_as_float((k0 & 0x80000000u) ? (k0 ^ 0x80000000u) : ~k0);
#pragma unroll
                for (int r = 0; r < 16; ++r) {
                    const unsigned kk = best[r] & ~16383u;
                    const float s = __uint_as_float((kk & 0x80000000u) ? (kk ^ 0x80000000u) : ~kk);
                    e[r] = __expf(s - s0); dsum += e[r];
                }
                const float inv = 1.f / dsum;
                const size_t pr = (size_t)(m0 + row) * 8 + (hp >> 1);
                uint4 o0, o1;
                o0.x = (best[0] & 16383u) | ((best[1] & 16383u) << 16); o0.y = (best[2] & 16383u) | ((best[3] & 16383u) << 16);
                o0.z = (best[4] & 16383u) | ((best[5] & 16383u) << 16); o0.w = (best[6] & 16383u) | ((best[7] & 16383u) << 16);
                o1.x = (best[8] & 16383u) | ((best[9] & 16383u) << 16); o1.y = (best[10] & 16383u) | ((best[11] & 16383u) << 16);
                o1.z = (best[12] & 16383u) | ((best[13] & 16383u) << 16); o1.w = (best[14] & 16383u) | ((best[15] & 16383u) << 16);
                *(uint4*)(eid + pr * 16) = o0; *(uint4*)(eid + pr * 16 + 8) = o1;
#pragma unroll
                for (int r4 = 0; r4 < 4; ++r4)
                    *(float4*)(gate + pr * 16 + r4 * 4) = make_float4(e[r4 * 4] * inv, e[r4 * 4 + 1] * inv, e[r4 * 4 + 2] * inv, e[r4 * 4 + 3] * inv);
            }
        }
        __syncthreads();
    }
};

__device__ __forceinline__ int win_colmap(int n) {
    if (n < 1280) return n;
    if (n < 1792) { const int j = n - 1280, gI = j >> 3, w8 = j & 7, ch = gI * 4 + (w8 & 3); return (w8 & 4) ? 1560 + ch : 1304 + ch; }
    if (n < 2048) return 1816 + (n - 1792);
    if (n < 2072) return 1280 + (n - 2048);
    return -1;
}
template <bool WINMAP>
__device__ __forceinline__ void tconv(const float* __restrict__ src, int ld_src, int K, int Nd, const float* __restrict__ g, bf16_t* __restrict__ dst,
                                      int tid, int bid, int G, int& base, float* tl  ) {
    const int nkt = K >> 6, ntiles = (Nd >> 6) * nkt;
    const int first = (bid + G - (base % G)) % G;
    for (int t = first; t < ntiles; t += G) {
        const int n0 = (t / nkt) * 64, k0 = (t % nkt) * 64;
        {
            const int kr = tid >> 4, nc = (tid & 15) * 4;
            const int n = n0 + nc;
            const int sc = WINMAP ? win_colmap(n) : n;
#pragma unroll
            for (int ps = 0; ps < 4; ++ps) {
                const int k = kr + ps * 16;
                float4 v = make_float4(0.f, 0.f, 0.f, 0.f);
                if (sc >= 0) v = *(const float4*)(src + (size_t)(k0 + k) * ld_src + sc);
                tl[k * 65 + nc] = v.x; tl[k * 65 + nc + 1] = v.y; tl[k * 65 + nc + 2] = v.z; tl[k * 65 + nc + 3] = v.w;
            }
        }
        __syncthreads();
        {
            const int n = tid >> 2, kq = (tid & 3) * 16;
            float v[16];
#pragma unroll
            for (int i = 0; i < 16; ++i) v[i] = tl[(kq + i) * 65 + n] * (g ? g[k0 + kq + i] : 1.f);
            uint4 o0, o1;
            o0.x = pack2(v[0], v[1]); o0.y = pack2(v[2], v[3]); o0.z = pack2(v[4], v[5]); o0.w = pack2(v[6], v[7]);
            o1.x = pack2(v[8], v[9]); o1.y = pack2(v[10], v[11]); o1.z = pack2(v[12], v[13]); o1.w = pack2(v[14], v[15]);
            bf16_t* d = dst + (size_t)(n0 + n) * K + k0 + kq;
            *(uint4*)d = o0; *(uint4*)(d + 8) = o1;
        }
        __syncthreads();
    }
    base += ntiles;
}
__device__ __forceinline__ void conv_bf16(const float* __restrict__ src, bf16_t* __restrict__ dst, size_t n, int gtid, int gsize) {
    const size_t n8 = n >> 3;
    for (size_t i = gtid; i < n8; i += gsize) {
        const float4 a = *(const float4*)(src + i * 8), b = *(const float4*)(src + i * 8 + 4);
        uint4 o; o.x = pack2(a.x, a.y); o.y = pack2(a.z, a.w); o.z = pack2(b.x, b.y); o.w = pack2(b.z, b.w);
        *(uint4*)(dst + i * 8) = o;
    }
}
constexpr float U_SCALE = 64.f, V_SCALE = 5.657f;
template<bool PERM>
__device__ __forceinline__ void conv_fp4(const float* __restrict__ src, unsigned char* __restrict__ dst, size_t n, float scale, int gtid, int gsize) {
    const size_t n32 = n >> 5;
    for (size_t o = gtid; o < n32; o += gsize) {
        const size_t row = o >> 5; const int un = (int)(o & 31);
        const float* s = src + row * 1024 + (PERM ? (un >> 4) * 512 + (un & 15) * 8 : un * 32);
        unsigned wd[4];
#pragma unroll
        for (int k = 0; k < 4; ++k) {
            const float* sk = s + k * (PERM ? 128 : 8);
            const float4 a = *(const float4*)sk, b = *(const float4*)(sk + 4);
            unsigned w = 0u;
            w = __builtin_amdgcn_cvt_scalef32_pk_fp4_f32(w, a.x * scale, a.y * scale, 1.0f, 0);
            w = __builtin_amdgcn_cvt_scalef32_pk_fp4_f32(w, a.z * scale, a.w * scale, 1.0f, 1);
            w = __builtin_amdgcn_cvt_scalef32_pk_fp4_f32(w, b.x * scale, b.y * scale, 1.0f, 2);
            w = __builtin_amdgcn_cvt_scalef32_pk_fp4_f32(w, b.z * scale, b.w * scale, 1.0f, 3);
            wd[k] = w;
        }
        *(uint4*)(dst + o * 16) = make_uint4(wd[0], wd[1], wd[2], wd[3]);
    }
}
__device__ __forceinline__ void row_prep(const float* __restrict__ src, bf16_t* __restrict__ dstb, float* __restrict__ rstd, float* __restrict__ parts, int nrows, int gwave, int nwaves, int lane) {
    for (int row = gwave; row < nrows; row += nwaves) {
        const float* p = src + (size_t)row * DM + lane * 16;
        float v[16]; float ss = 0.f;
#pragma unroll
        for (int i = 0; i < 4; ++i) { const float4 t = *(const float4*)(p + i * 4); v[i * 4] = t.x; v[i * 4 + 1] = t.y; v[i * 4 + 2] = t.z; v[i * 4 + 3] = t.w; }
#pragma unroll
        for (int i = 0; i < 16; ++i) ss += v[i] * v[i];
        float s4 = ss + __shfl_xor(ss, 1); s4 += __shfl_xor(s4, 2);
        if (parts && (lane & 3) == 0) parts[(size_t)row * 16 + (lane >> 2)] = s4;
        ss = wave_sum(ss);
        uint4 o0, o1;
        o0.x = pack2(v[0], v[1]); o0.y = pack2(v[2], v[3]); o0.z = pack2(v[4], v[5]); o0.w = pack2(v[6], v[7]);
        o1.x = pack2(v[8], v[9]); o1.y = pack2(v[10], v[11]); o1.z = pack2(v[12], v[13]); o1.w = pack2(v[14], v[15]);
        *(uint4*)(dstb + (size_t)row * DM + lane * 16) = o0;
        *(uint4*)(dstb + (size_t)row * DM + lane * 16 + 8) = o1;
        if (rstd && lane == 0) rstd[row] = rsqrtf(ss * (1.f / DM) + EPS);
    }
}
__device__ __forceinline__ void sincos_d(double ang, float& c, float& s) {
    const double k = rint(ang * 0.63661977236758134308);
    double r = fma(-k, 1.57079632679489655800e+00, ang);
    r = fma(-k, 6.12323399573676603587e-17, r);
    const double r2 = r * r;
    double sp = -1.0 / 39916800.0; sp = fma(sp, r2, 1.0 / 362880.0); sp = fma(sp, r2, -1.0 / 5040.0); sp = fma(sp, r2, 1.0 / 120.0); sp = fma(sp, r2, -1.0 / 6.0); sp = fma(sp, r2, 1.0);
    const double sn = sp * r;
    double cp = 1.0 / 479001600.0; cp = fma(cp, r2, -1.0 / 3628800.0); cp = fma(cp, r2, 1.0 / 40320.0); cp = fma(cp, r2, -1.0 / 720.0); cp = fma(cp, r2, 1.0 / 24.0); cp = fma(cp, r2, -0.5); cp = fma(cp, r2, 1.0);
    const int q = ((int)k) & 3;
    double cc, ss;
    if (q == 0) { cc = cp; ss = sn; } else if (q == 1) { cc = -sn; ss = cp; } else if (q == 2) { cc = -cp; ss = -sn; } else { cc = sn; ss = -cp; }
    c = (float)cc; s = (float)ss;
}

__device__ __forceinline__ void conv_weights(const Params& p, int l, int mask, char* smem) {
    const int tid0 = launder(threadIdx.x);
    const int gtid = blockIdx.x * NTHREADS + tid0, gsize = gridDim.x * NTHREADS;
    char* ws = launder_p(p.ws);
    int tbase = 0;
    float* tl = (float*)smem;
    const int bid_ = blockIdx.x, G_ = gridDim.x;
    char* W = ws + WS_W + l * W_STRIDE;
    __syncthreads();
    if (mask & 1) tconv<true >(p.in[4] + (size_t)l * 1024 * 2072, 2072, 1024, NWIN, p.in[3] + l * 1024, (bf16_t*)(W + W_WIN), tid0, bid_, G_, tbase, tl);
    if (mask & 2) tconv<false>(p.in[20] + (size_t)l * 1024 * 2048, 2048, 1024, 2048, p.in[18] + l * 1024, (bf16_t*)(W + W_XWKV), tid0, bid_, G_, tbase, tl);
    if (mask & 4) {
        tconv<false>(p.in[16] + (size_t)l * 1024 * 1024, 1024, 1024, 1024, nullptr, (bf16_t*)(W + W_WOUT), tid0, bid_, G_, tbase, tl);
        tconv<false>(p.in[19] + (size_t)l * 1024 * 1024, 1024, 1024, 1024, p.in[17] + l * 1024, (bf16_t*)(W + W_XWQ), tid0, bid_, G_, tbase, tl);
        tconv<false>(p.in[21] + (size_t)l * 1024 * 1024, 1024, 1024, 1024, nullptr, (bf16_t*)(W + W_XWO), tid0, bid_, G_, tbase, tl);
        tconv<false>(p.in[23] + (size_t)l * 1024 * 2048, 2048, 1024, 2048, p.in[22] + l * 1024, (bf16_t*)(W + W_PWQ), tid0, bid_, G_, tbase, tl);
        for (int kv = 0; kv < 2; ++kv) {
            tconv<false>(p.in[6] + ((size_t)l * 2 + kv) * 2048 * 256, 256, 2048, 256, nullptr, (bf16_t*)(W + W_CW1) + (size_t)kv * 256 * 2048, tid0, bid_, G_, tbase, tl);
            tconv<false>(p.in[7] + ((size_t)l * 2 + kv) * 256 * 64, 64, 256, 64, nullptr, (bf16_t*)(W + W_CW2) + (size_t)kv * 64 * 256, tid0, bid_, G_, tbase, tl);
        }
        tconv<false>(p.in[12] + (size_t)l * 256 * 256, 256, 256, 256, nullptr, (bf16_t*)(W + W_PW), tid0, bid_, G_, tbase, tl);
        for (int g = 0; g < 4; ++g)
            tconv<false>(p.in[14] + ((size_t)l * 4 + g) * 64 * 64, 64, 64, 64, nullptr, (bf16_t*)(W + W_POOLW) + (size_t)g * 64 * 64, tid0, bid_, G_, tbase, tl);
        conv_bf16(p.in[24] + (size_t)l * 2 * 128 * 128, (bf16_t*)(W + W_SUBK), 2 * 128 * 128, gtid, gsize);
    }
    if (mask & 8) {
        for (int u = bid_; u < 64; u += G_) {
            const int kv = u >> 5, kc = u & 31;
            const float* pe = p.in[5] + ((size_t)l * 2 + kv) * 2048 + kc * 64;
            const float* w1 = p.in[6] + ((size_t)l * 2 + kv) * 2048 * 256 + (size_t)kc * 64 * 256;
            float s = 0.f;
            for (int k = 0; k < 64; ++k) s += pe[k] * w1[(size_t)k * 256 + tid0];
            ((float*)(ws + WS_CBPART))[((size_t)(l * 2 + kv) * 32 + kc) * 256 + tid0] = s;
        }
    }
    __syncthreads();
}

__device__ __forceinline__ void phase_prep(const Params& p, char* smem) {
    const int tid0 = launder(threadIdx.x);
    const int gtid = blockIdx.x * NTHREADS + tid0, gsize = gridDim.x * NTHREADS;
    const int lane = tid0 & 63, gwave = gtid >> 6, nwaves = gsize >> 6;
    char* ws = launder_p(p.ws);
    conv_weights(p, 0, 1 | 2 | 8, smem);
    conv_weights(p, 1, 2, smem);
    row_prep(p.in[0], (bf16_t*)(ws + WS_XB), nullptr, (float*)(ws + WS_PARTS0), T_, gwave, nwaves, lane);
    row_prep(p.in[1], (bf16_t*)(ws + WS_MEMB), (float*)(ws + WS_RSTDM), nullptr, 1024, gwave, nwaves, lane);
    const int* pos = (const int*)p.in[2];
    float* rope = (float*)(ws + WS_ROPE);
    for (int i = gtid; i < T_ * 8; i += gsize) {
        const int t = i >> 3, f = i & 7;
        float c, s; sincos_d((double)pos[t] * p.freq[f], c, s);
        rope[(size_t)t * 16 + f * 2] = c; rope[(size_t)t * 16 + f * 2 + 1] = s;
    }
    for (int i = gtid; i < 32768 / 4; i += gsize) ((unsigned*)(ws + WS_CTL))[i] = 0u;
    if (gtid < 8) ((unsigned*)(ws + WS_KNMAX))[gtid] = 0u;
    unsigned* kz = (unsigned*)(ws + WS_KCMP);
    for (int i = gtid; i < (512 * 1024) / 4; i += gsize) kz[i] = 0u;
}

__device__ __forceinline__ void convpool_tile(const Params& p, int l, int item, char* smem) {
    const int tid = launder(threadIdx.x), lane = tid & 63, w = tid >> 6;
    char* ws = launder_p(p.ws); char* W = ws + WS_W + l * W_STRIDE;
    const int t0 = item * 16, b = t0 / S_, s0 = t0 % S_;
    const bf16_t* glu = (const bf16_t*)(ws + WS_GLU);
    const bf16_t* zp = (const bf16_t*)(ws + WS_ZP);
    bf16_t* mix = (bf16_t*)(ws + WS_MIX);
    bf16_t* gw = (bf16_t*)smem;
    bf16_t* zw = gw + 46 * 256;
    float* ybuf = (float*)(smem + 23552 + 15872);
    bf16_t* at = (bf16_t*)(smem + 23552 + 15872 + 16384);
    uint4 wg[6], wz[4];
#pragma unroll
    for (int i = 0; i < 6; ++i) {
        const int c = tid + i * NTHREADS, r = c >> 5, ch = c & 31, s = s0 - 30 + r;
        wg[i] = make_uint4(0u, 0u, 0u, 0u);
        if (c < 46 * 32 && s >= 0) wg[i] = *(const uint4*)(glu + ((size_t)(b * S_ + s)) * 256 + ch * 8);
    }
#pragma unroll
    for (int i = 0; i < 4; ++i) {
        const int c = tid + i * NTHREADS, r = c >> 5, ch = c & 31, s = s0 - 15 + r;
        wz[i] = make_uint4(0u, 0u, 0u, 0u);
        if (c < 31 * 32 && s >= 0) wz[i] = *(const uint4*)(zp + ((size_t)(b * S_ + s)) * 256 + ch * 8);
    }
    const float* cw = p.in[8] + (size_t)l * 31 * 256;
    float wk[31];
#pragma unroll
    for (int k = 0; k < 31; ++k) wk[k] = cw[k * 256 + tid];
    const float cb = p.in[9][l * 256 + tid];
#pragma unroll
    for (int i = 0; i < 6; ++i) { const int c = tid + i * NTHREADS; if (c < 46 * 32) *(uint4*)(gw + (c >> 5) * 256 + (c & 31) * 8) = wg[i]; }
#pragma unroll
    for (int i = 0; i < 4; ++i) { const int c = tid + i * NTHREADS; if (c < 31 * 32) *(uint4*)(zw + (c >> 5) * 256 + (c & 31) * 8) = wz[i]; }
    const bf16_t* pw = (const bf16_t*)(W + W_PW);
    const int fsrc = 4 * (4 * (lane & 15) + (lane >> 4));
    uint4 bbr[8][4];
#pragma unroll
    for (int kk = 0; kk < 8; ++kk)
#pragma unroll
        for (int ni = 0; ni < 4; ++ni) bbr[kk][ni] = *(const uint4*)(pw + (size_t)(w * 64 + ni * 16 + (lane >> 2)) * 256 + kk * 32 + (lane & 3) * 8);
    __syncthreads();
    {
        const int c = tid;
        float a[16];
#pragma unroll
        for (int tl = 0; tl < 16; ++tl) a[tl] = cb;
#pragma unroll
        for (int r = 0; r < 46; ++r) {
            const float g = bf2f(gw[r * 256 + c]);
#pragma unroll
            for (int tl = 0; tl < 16; ++tl) { const int k = r - tl; if (k >= 0 && k < 31) a[tl] += wk[k] * g; }
        }
#pragma unroll
        for (int tl = 0; tl < 16; ++tl) ybuf[tl * 256 + c] = a[tl];
    }
    __syncthreads();
    {
        const float* lg = p.in[10] + l * 256; const float* lb = p.in[11] + l * 256;
        const float4 g4 = *(const float4*)(lg + lane * 4), b4 = *(const float4*)(lb + lane * 4);
#pragma unroll 1
        for (int tl = w * 4; tl < w * 4 + 4; ++tl) {
            const float4 v = *(const float4*)(ybuf + tl * 256 + lane * 4);
            const float mean = wave_sum(v.x + v.y + v.z + v.w) * (1.f / 256.f);
            const float d0 = v.x - mean, d1 = v.y - mean, d2 = v.z - mean, d3 = v.w - mean;
            const float var = wave_sum(d0 * d0 + d1 * d1 + d2 * d2 + d3 * d3) * (1.f / 256.f);
            const float rs = rsqrtf(var + EPS);
            float y0 = d0 * rs * g4.x + b4.x, y1 = d1 * rs * g4.y + b4.y, y2 = d2 * rs * g4.z + b4.z, y3 = d3 * rs * g4.w + b4.w;
            y0 *= sigmoidf_(y0); y1 *= sigmoidf_(y1); y2 *= sigmoidf_(y2); y3 *= sigmoidf_(y3);
            uint2 o; o.x = pack2(y0, y1); o.y = pack2(y2, y3);
            *(uint2*)(at + tl * 264 + lane * 4) = o;
        }
    }
    __syncthreads();
    {
        f32x4 acc[4];
#pragma unroll
        for (int j = 0; j < 4; ++j) acc[j] = (f32x4){0.f, 0.f, 0.f, 0.f};
#pragma unroll
        for (int kk = 0; kk < 8; ++kk) {
            const bf16x8 av = *(const bf16x8*)(at + (lane & 15) * 264 + kk * 32 + (lane >> 4) * 8);
#pragma unroll
            for (int ni = 0; ni < 4; ++ni) {
                const uint4 f = make_uint4((unsigned)__builtin_amdgcn_ds_bpermute(fsrc, (int)bbr[kk][ni].x), (unsigned)__builtin_amdgcn_ds_bpermute(fsrc, (int)bbr[kk][ni].y),
                                           (unsigned)__builtin_amdgcn_ds_bpermute(fsrc, (int)bbr[kk][ni].z), (unsigned)__builtin_amdgcn_ds_bpermute(fsrc, (int)bbr[kk][ni].w));
                acc[ni] = mfma16(__builtin_bit_cast(bf16x8, f), av, acc[ni]);
            }
        }
        const float* pb = p.in[13] + l * 256;
#pragma unroll
        for (int ni = 0; ni < 4; ++ni) {
            const int col = w * 64 + ni * 16 + (lane >> 4) * 4; const float4 bv = *(const float4*)(pb + col);
            *(uint2*)(mix + (size_t)(t0 + (lane & 15)) * DM + 512 + col) = make_uint2(pack2(acc[ni][0] + bv.x, acc[ni][1] + bv.y), pack2(acc[ni][2] + bv.z, acc[ni][3] + bv.w));
        }
    }
    __syncthreads();
    const int gi = w;
    const bf16_t* pwt = (const bf16_t*)(W + W_POOLW) + (size_t)gi * 64 * 64;
    uint4 pbr[2][4];
#pragma unroll
    for (int kk = 0; kk < 2; ++kk)
#pragma unroll
        for (int ni = 0; ni < 4; ++ni) pbr[kk][ni] = *(const uint4*)(pwt + (size_t)(ni * 16 + (lane >> 2)) * 64 + kk * 32 + (lane & 3) * 8);
    {
        const int c = tid, win = 2 << gi;
        float z[31];
#pragma unroll
        for (int r = 0; r < 31; ++r) z[r] = bf2f(zw[r * 256 + c]);
        float s2[31], s4[31], s8[31], s16[31];
#pragma unroll
        for (int r = 0; r < 31; ++r) s2[r] = z[r] + (r >= 1 ? z[r - 1] : 0.f);
#pragma unroll
        for (int r = 0; r < 31; ++r) s4[r] = s2[r] + (r >= 2 ? s2[r - 2] : 0.f);
#pragma unroll
        for (int r = 0; r < 31; ++r) s8[r] = s4[r] + (r >= 4 ? s4[r - 4] : 0.f);
#pragma unroll
        for (int r = 0; r < 31; ++r) s16[r] = s8[r] + (r >= 8 ? s8[r - 8] : 0.f);
#pragma unroll
        for (int tl = 0; tl < 16; ++tl) {
            const int s = s0 + tl; const int cnt = (s + 1 < win) ? (s + 1) : win;
            const float sum = gi == 0 ? s2[15 + tl] : (gi == 1 ? s4[15 + tl] : (gi == 2 ? s8[15 + tl] : s16[15 + tl]));
            const float m = sum / (float)cnt - z[15 + tl];
            at[tl * 264 + c] = f2bf(m);
        }
    }
    __syncthreads();
    {
        f32x4 acc[4];
#pragma unroll
        for (int j = 0; j < 4; ++j) acc[j] = (f32x4){0.f, 0.f, 0.f, 0.f};
#pragma unroll
        for (int kk = 0; kk < 2; ++kk) {
            const bf16x8 av = *(const bf16x8*)(at + (lane & 15) * 264 + gi * 64 + kk * 32 + (lane >> 4) * 8);
#pragma unroll
            for (int ni = 0; ni < 4; ++ni) {
                const uint4 f = make_uint4((unsigned)__builtin_amdgcn_ds_bpermute(fsrc, (int)pbr[kk][ni].x), (unsigned)__builtin_amdgcn_ds_bpermute(fsrc, (int)pbr[kk][ni].y),
                                           (unsigned)__builtin_amdgcn_ds_bpermute(fsrc, (int)pbr[kk][ni].z), (unsigned)__builtin_amdgcn_ds_bpermute(fsrc, (int)pbr[kk][ni].w));
                acc[ni] = mfma16(__builtin_bit_cast(bf16x8, f), av, acc[ni]);
            }
        }
        const float* psc = p.in[15] + l * 256;
#pragma unroll
        for (int ni = 0; ni < 4; ++ni) {
            const int col = gi * 64 + ni * 16 + (lane >> 4) * 4; const float4 sc = *(const float4*)(psc + col);
            *(uint2*)(mix + (size_t)(t0 + (lane & 15)) * DM + 768 + col) = make_uint2(pack2(acc[ni][0] * sc.x, acc[ni][1] * sc.y), pack2(acc[ni][2] * sc.z, acc[ni][3] * sc.w));
        }
    }
    __syncthreads();
}

struct FlashState { float lp[2]; f32x4 o[4][2]; };

__device__ __forceinline__ void nsa_issue_tile(const bf16_t* __restrict__ ksrc, int kstride, const bf16_t* __restrict__ vtsrc, int vtstride, bf16_t* Kt, bf16_t* Vt, int w, int lane) {
    const int row_in = lane >> 3, gch = ((lane & 7) ^ row_in) * 8;
#pragma unroll
    for (int i = 0; i < 2; ++i) {
        const int piece = w * 2 + i, row = piece * 8 + row_in;
        glds16(ksrc + (size_t)row * kstride + gch, Kt + piece * 512);
        glds16(vtsrc + (size_t)row * vtstride + gch, Vt + piece * 512);
    }
}

template <int KIND, bool STATS_ONLY, bool NORMALIZE>
__device__ __forceinline__ void nsa_tile_step(FlashState& st, const bf16x8 (&qa)[2][2], const bf16_t* Kt, const bf16_t* Vt, bf16_t* Pw, int lane,
                                              int j, int pos0, const unsigned long long* mask64, const int* nmaxv, const float (&mb2)[2], const float (&invl)[2]) {
    const int lc = lane & 15, lq = lane >> 4;
    constexpr float C2 = 0.125f * 1.4426950408889634f;
    bf16x8 kb[4][2];
#pragma unroll
    for (int ni = 0; ni < 4; ++ni)
#pragma unroll
        for (int kk = 0; kk < 2; ++kk) kb[ni][kk] = *(const bf16x8*)(Kt + (ni * 16 + lc) * 64 + (((kk * 4 + lq) ^ (lc & 7)) << 3));
    bf16x8 pb[2][2];
#pragma unroll
    for (int mi = 0; mi < 2; ++mi) {
        f32x4 s[4];
#pragma unroll
        for (int ni = 0; ni < 4; ++ni) {
            s[ni] = (f32x4){0.f, 0.f, 0.f, 0.f};
            s[ni] = mfma16(kb[ni][0], qa[mi][0], s[ni]);
            s[ni] = mfma16(kb[ni][1], qa[mi][1], s[ni]);
        }
        const int tl = mi * 16 + lc;
        bool rowsel = true; int lim = 0;
        if (KIND == 1) rowsel = (mask64[tl] >> j) & 1ull;
        if (KIND == 2 || KIND == 3) lim = pos0 + tl;
        if (KIND == 4) lim = nmaxv[tl] - j * 64;
        float p[4][4]; float psum = 0.f;
        const float nshift = (KIND == 1 && !rowsel) ? -__builtin_inff() : -mb2[mi];
#pragma unroll
        for (int ni = 0; ni < 4; ++ni)
#pragma unroll
            for (int r = 0; r < 4; ++r) {
                const int kl = ni * 16 + lq * 4 + r;
                const float e = __builtin_amdgcn_exp2f(fmaf(s[ni][r], C2, nshift));
                bool ok = true;
                if (KIND == 2 || KIND == 4) ok = kl <= lim;
                if (KIND == 3) ok = kl > lim;
                float pv = ok ? e : 0.f;
                if (NORMALIZE) pv *= invl[mi];
                p[ni][r] = pv; psum += pv;
            }
        if (!NORMALIZE) st.lp[mi] += psum;
        if (!STATS_ONLY) {
#pragma unroll
            for (int sx = 0; sx < 2; ++sx) {
                const unsigned w0 = pack2(p[2 * sx][0], p[2 * sx][1]), w1 = pack2(p[2 * sx][2], p[2 * sx][3]);
                const unsigned w2 = pack2(p[2 * sx + 1][0], p[2 * sx + 1][1]), w3 = pack2(p[2 * sx + 1][2], p[2 * sx + 1][3]);
                const uint4 pk = make_uint4(w0, w1, w2, w3);
                pb[mi][sx] = __builtin_bit_cast(bf16x8, pk);
                if (NORMALIZE) {
                    *(uint2*)(Pw + tl * 72 + (2 * sx) * 16 + lq * 4) = make_uint2(w0, w1);
                    *(uint2*)(Pw + tl * 72 + (2 * sx + 1) * 16 + lq * 4) = make_uint2(w2, w3);
                }
            }
        }
    }
    if (!STATS_ONLY) {
#pragma unroll
        for (int nd = 0; nd < 4; ++nd) {
            const int row = nd * 16 + lc;
            bf16x8 va[2];
#pragma unroll
            for (int sx = 0; sx < 2; ++sx) {
                const int c0 = 4 * sx + (lq >> 1), c1 = c0 + 2;
                const uint2 lo = *(const uint2*)(Vt + row * 64 + ((c0 ^ (lc & 7)) << 3) + (lq & 1) * 4);
                const uint2 hi = *(const uint2*)(Vt + row * 64 + ((c1 ^ (lc & 7)) << 3) + (lq & 1) * 4);
                va[sx] = __builtin_bit_cast(bf16x8, make_uint4(lo.x, lo.y, hi.x, hi.y));
            }
#pragma unroll
            for (int mi = 0; mi < 2; ++mi) {
                st.o[nd][mi] = mfma16(va[0], pb[mi][0], st.o[nd][mi]);
                st.o[nd][mi] = mfma16(va[1], pb[mi][1], st.o[nd][mi]);
            }
        }
    }
}

__device__ __forceinline__ void flash_reset(FlashState& st) {
    st.lp[0] = 0.f; st.lp[1] = 0.f;
#pragma unroll
    for (int nd = 0; nd < 4; ++nd)
#pragma unroll
        for (int mi = 0; mi < 2; ++mi) st.o[nd][mi] = (f32x4){0.f, 0.f, 0.f, 0.f};
}

template <bool FIRST, bool NORMALIZED>
__device__ __forceinline__ void nsa_emit(const FlashState& st, const float* __restrict__ gates, bf16_t* __restrict__ mix, int tok0, int kvh, int g, int gidx, int lane_) {
    const int lane = launder(lane_);
    const int lc = lane & 15, lq = lane >> 4;
#pragma unroll
    for (int mi = 0; mi < 2; ++mi) {
        const int t = tok0 + mi * 16 + lc;
        const float gt = gates[(size_t)t * 24 + kvh * 12 + g * 3 + gidx];
        float sc;
        if (NORMALIZED) sc = gt;
        else { float l = st.lp[mi]; l += __shfl_xor(l, 16); l += __shfl_xor(l, 32); sc = l > 0.f ? gt / l : 0.f; }
#pragma unroll
        for (int nd = 0; nd < 4; ++nd) {
            bf16_t* dst = mix + (size_t)t * DM + (kvh * 4 + g) * 64 + nd * 16 + lq * 4;
            float v0 = st.o[nd][mi][0] * sc, v1 = st.o[nd][mi][1] * sc, v2 = st.o[nd][mi][2] * sc, v3 = st.o[nd][mi][3] * sc;
            if (!FIRST) { const uint2 old = *(const uint2*)dst;
                v0 += __uint_as_float(old.x << 16); v1 += __uint_as_float(old.x & 0xFFFF0000u); v2 += __uint_as_float(old.y << 16); v3 += __uint_as_float(old.y & 0xFFFF0000u); }
            *(uint2*)dst = make_uint2(pack2(v0, v1), pack2(v2, v3));
        }
    }
}

__device__ __forceinline__ void nsa_item(const Params& p, int l, int item, char* smem) {
    const int tid = launder(threadIdx.x), lane = tid & 63, g = tid >> 6;
    char* ws = launder_p(p.ws);
    const int qi = 127 - (item >> 3), bk = item & 7, b = bk >> 1, kvh = bk & 1;
    const int cur = qi >> 1, pos0 = (qi & 1) * 32;
    const int tok0 = b * S_ + qi * 32;
    bf16_t* Kb = (bf16_t*)smem;
    bf16_t* Vb = Kb + 2 * 4096;
    bf16_t* Pall = Vb + 2 * 4096;
    bf16_t* Pw = Pall + g * 2304;
    float* impf = (float*)(smem + 32768 + 18432);
    unsigned long long* mask64 = (unsigned long long*)(smem + 32768 + 18432 + 8192);
    int* nmaxv = (int*)(smem + 32768 + 18432 + 8192 + 256);
    float* qnl = (float*)(smem + 32768 + 18432 + 8192 + 512) + g * 32;
    const int wv = __builtin_amdgcn_readfirstlane(g);
    const bf16_t* q = (const bf16_t*)(ws + WS_Q);
    const float* gates = (const float*)(ws + WS_GATES);
    bf16_t* mix = (bf16_t*)(ws + WS_MIX);
    unsigned* knm = (unsigned*)(ws + WS_KNMAX) + l * 4;
    constexpr float C2 = 0.125f * 1.4426950408889634f;

    bf16x8 qa[2][2];
#pragma unroll
    for (int mi = 0; mi < 2; ++mi)
#pragma unroll
        for (int kk = 0; kk < 2; ++kk)
            qa[mi][kk] = *(const bf16x8*)(q + (size_t)(tok0 + mi * 16 + (lane & 15)) * 512 + (kvh * 4 + g) * 64 + kk * 32 + (lane >> 4) * 8);
    float qn2[2];
#pragma unroll
    for (int mi = 0; mi < 2; ++mi) {
        float ss = 0.f;
#pragma unroll
        for (int kk = 0; kk < 2; ++kk)
#pragma unroll
            for (int e = 0; e < 8; ++e) { const float f = bf2f((bf16_t)qa[mi][kk][e]); ss += f * f; }
        ss += __shfl_xor(ss, 16); ss += __shfl_xor(ss, 32);
        qn2[mi] = sqrtf(ss) * C2;
    }
    const float kmax_cmp = sqrtf(__uint_as_float(__hip_atomic_load(knm + 3, __ATOMIC_RELAXED, __HIP_MEMORY_SCOPE_AGENT)));
    const float kmax_sel = sqrtf(__uint_as_float(__hip_atomic_load(knm + 1, __ATOMIC_RELAXED, __HIP_MEMORY_SCOPE_AGENT)));
    const float kmax_win = sqrtf(__uint_as_float(__hip_atomic_load(knm + 2, __ATOMIC_RELAXED, __HIP_MEMORY_SCOPE_AGENT)));

    for (int i = tid; i < 32 * 64; i += NTHREADS) impf[i] = 0.f;
    if (tid < 32) { const int t = qi * 32 + tid; nmaxv[tid] = (t >= 31) ? min((t - 31) >> 4, NCMP - 1) : -1; }
    const int tmax = qi * 32 + 31;
    const int ncmp_tiles = (min((tmax - 31) >> 4, NCMP - 1) >> 6) + 1;
    const bf16_t* kcmp = (const bf16_t*)(ws + WS_KCMP) + (size_t)(b * 2 + kvh) * 256 * 64;
    const bf16_t* vcmpT = (const bf16_t*)(ws + WS_VCMPT) + (size_t)(b * 2 + kvh) * 64 * 256;

    FlashState st;
    flash_reset(st);
    float mb2[2], invl[2];
    mb2[0] = qn2[0] * kmax_cmp; mb2[1] = qn2[1] * kmax_cmp; invl[0] = 0.f; invl[1] = 0.f;
    nsa_issue_tile(kcmp, 64, vcmpT, 256, Kb, Vb, wv, lane);
    for (int j = 0; j < ncmp_tiles; ++j) {
        asm volatile("s_waitcnt vmcnt(0)" ::: "memory");
        __syncthreads();
        if (j + 1 < ncmp_tiles) nsa_issue_tile(kcmp + (size_t)(j + 1) * 64 * 64, 64, vcmpT + (j + 1) * 64, 256, Kb + ((j + 1) & 1) * 4096, Vb + ((j + 1) & 1) * 4096, wv, lane);
        nsa_tile_step<4, true, false>(st, qa, Kb + (j & 1) * 4096, Vb + (j & 1) * 4096, Pw, lane, j, pos0, mask64, nmaxv, mb2, invl);
    }
#pragma unroll
    for (int mi = 0; mi < 2; ++mi) { float lsum = st.lp[mi]; lsum += __shfl_xor(lsum, 16); lsum += __shfl_xor(lsum, 32); invl[mi] = lsum > 0.f ? 1.f / lsum : 0.f; }
    __syncthreads();
    nsa_issue_tile(kcmp, 64, vcmpT, 256, Kb, Vb, wv, lane);
    for (int j = 0; j < ncmp_tiles; ++j) {
        asm volatile("s_waitcnt vmcnt(0)" ::: "memory");
        __syncthreads();
        if (j + 1 < ncmp_tiles) nsa_issue_tile(kcmp + (size_t)(j + 1) * 64 * 64, 64, vcmpT + (j + 1) * 64, 256, Kb + ((j + 1) & 1) * 4096, Vb + ((j + 1) & 1) * 4096, wv, lane);
        nsa_tile_step<4, false, true>(st, qa, Kb + (j & 1) * 4096, Vb + (j & 1) * 4096, Pw, lane, j, pos0, mask64, nmaxv, mb2, invl);
        __syncthreads();
        {
            const int tl = tid & 31, part = tid >> 5;
            float a0 = 0.f, a1 = 0.f, a2 = 0.f;
#pragma unroll
            for (int gg = 0; gg < 4; ++gg) {
                const bf16_t* pr = Pall + gg * 2304 + tl * 72;
                const uint2 q0 = *(const uint2*)(pr + 4 * part), q1 = *(const uint2*)(pr + 4 * (part + 8));
                const float m0 = bf2f(pr[part > 0 ? 4 * part - 1 : 0]), m1 = bf2f(pr[4 * (part + 8) - 1]), l63 = bf2f(pr[63]);
                a0 += (__uint_as_float(q0.x << 16) + __uint_as_float(q0.x & 0xFFFF0000u)) + (__uint_as_float(q0.y << 16) + __uint_as_float(q0.y & 0xFFFF0000u)) + (part > 0 ? m0 : 0.f);
                a1 += (__uint_as_float(q1.x << 16) + __uint_as_float(q1.x & 0xFFFF0000u)) + (__uint_as_float(q1.y << 16) + __uint_as_float(q1.y & 0xFFFF0000u)) + m1;
                a2 += l63;
            }
            const int js0 = j * 16 + part, js1 = js0 + 8, js2 = j * 16 + 16;
            if (js0 < 64) impf[tl * 64 + js0] += a0;
            if (js1 < 64) impf[tl * 64 + js1] += a1;
            if (part == 0 && js2 < 64) impf[tl * 64 + js2] += a2;
        }
    }
    nsa_emit<true, true>(st, gates, mix, tok0, kvh, g, 0, lane);
    __syncthreads();
    for (int tt = 0; tt < 8; ++tt) {
        const int tl = g * 8 + tt;
        const int jb = lane;
        float v = impf[tl * 64 + jb];
        const bool causal = jb <= cur;
        const bool forced = (jb == 0) || (jb == cur) || (jb == cur - 1);
        v = causal ? (forced ? 1e4f : v) : NEGF;
        const unsigned key = f2key(v);
        unsigned T = 0u;
        for (int bit = 31; bit >= 0; --bit) {
            const unsigned cand = T | (1u << bit);
            if (__popcll(__ballot(key >= cand)) >= 16) T = cand;
        }
        const unsigned long long gtm = __ballot(key > T), eqm = __ballot(key == T);
        const int need = 16 - __popcll(gtm);
        const int pos = (int)__builtin_amdgcn_mbcnt_hi((unsigned)(eqm >> 32), __builtin_amdgcn_mbcnt_lo((unsigned)eqm, 0u));
        const unsigned long long mk = __ballot(key > T || (key == T && pos < need));
        if (lane == 0) mask64[tl] = mk;
    }
    __syncthreads();
    unsigned long long uni = 0ull;
    for (int i = 0; i < 32; ++i) uni |= mask64[i];
    uni &= (cur == 63) ? ~0ull : ((1ull << (cur + 1)) - 1ull);
    {
        const bf16_t* ks = (const bf16_t*)(ws + WS_KS) + (size_t)b * S_ * 128 + kvh * 64;
        const bf16_t* vsT = (const bf16_t*)(ws + WS_VST) + (size_t)(b * 2 + kvh) * 64 * S_;
        flash_reset(st);
        mb2[0] = qn2[0] * kmax_sel; mb2[1] = qn2[1] * kmax_sel;
        unsigned long long rem = uni;
        int j = __builtin_ctzll(rem); rem &= rem - 1ull;
        nsa_issue_tile(ks + (size_t)j * 64 * 128, 128, vsT + j * 64, S_, Kb, Vb, wv, lane);
        int bufi = 0;
        for (;;) {
            asm volatile("s_waitcnt vmcnt(0)" ::: "memory");
            __syncthreads();
            const bool more = rem != 0ull;
            int jn = 0;
            if (more) { jn = __builtin_ctzll(rem); rem &= rem - 1ull;
                nsa_issue_tile(ks + (size_t)jn * 64 * 128, 128, vsT + jn * 64, S_, Kb + (bufi ^ 1) * 4096, Vb + (bufi ^ 1) * 4096, wv, lane); }
            if (j == cur) nsa_tile_step<2, false, false>(st, qa, Kb + bufi * 4096, Vb + bufi * 4096, Pw, lane, j, pos0, mask64, nmaxv, mb2, invl);
            else          nsa_tile_step<1, false, false>(st, qa, Kb + bufi * 4096, Vb + bufi * 4096, Pw, lane, j, pos0, mask64, nmaxv, mb2, invl);
            if (!more) break;
            j = jn; bufi ^= 1;
        }
        nsa_emit<false, false>(st, gates, mix, tok0, kvh, g, 1, lane);
    }
    {
        const bf16_t* kw = (const bf16_t*)(ws + WS_KW) + (size_t)b * S_ * 128 + kvh * 64;
        const bf16_t* vwT = (const bf16_t*)(ws + WS_VWT) + (size_t)(b * 2 + kvh) * 64 * S_;
        flash_reset(st);
        mb2[0] = qn2[0] * kmax_win; mb2[1] = qn2[1] * kmax_win;
        const int j0 = (cur >= 8 ? cur - 8 : 0);
        __syncthreads();
        nsa_issue_tile(kw + (size_t)j0 * 64 * 128, 128, vwT + j0 * 64, S_, Kb, Vb, wv, lane);
        for (int j = j0; j <= cur; ++j) {
            const int bi = (j - j0) & 1;
            asm volatile("s_waitcnt vmcnt(0)" ::: "memory");
            __syncthreads();
            if (j + 1 <= cur) nsa_issue_tile(kw + (size_t)(j + 1) * 64 * 128, 128, vwT + (j + 1) * 64, S_, Kb + (bi ^ 1) * 4096, Vb + (bi ^ 1) * 4096, wv, lane);
            if (j == cur)           nsa_tile_step<2, false, false>(st, qa, Kb + bi * 4096, Vb + bi * 4096, Pw, lane, j, pos0, mask64, nmaxv, mb2, invl);
            else if (j == cur - 8)  nsa_tile_step<3, false, false>(st, qa, Kb + bi * 4096, Vb + bi * 4096, Pw, lane, j, pos0, mask64, nmaxv, mb2, invl);
            else                    nsa_tile_step<0, false, false>(st, qa, Kb + bi * 4096, Vb + bi * 4096, Pw, lane, j, pos0, mask64, nmaxv, mb2, invl);
        }
        nsa_emit<false, false>(st, gates, mix, tok0, kvh, g, 2, lane);
    }
    __syncthreads();
}

__device__ __forceinline__ void xattn_item(const Params& p, int l, int item, char* smem) {
    const int tid = launder(threadIdx.x), lane = tid & 63, w = __builtin_amdgcn_readfirstlane(tid >> 6), lc = lane & 15, lq = lane >> 4;
    char* ws = launder_p(p.ws);
    const int h = item & 3, qt = item >> 2;
    const int tok0 = qt * 64 + w * 16, b = (qt * 64) / S_;
    const bf16_t* qx = (const bf16_t*)(ws + WS_QXA);
    const bf16_t* km = (const bf16_t*)(ws + WS_KMEM) + (size_t)l * (NB * 4 * 256 * 256) + (size_t)(b * 4 + h) * 256 * 256;
    const bf16_t* vmT = (const bf16_t*)(ws + WS_VMEMT) + (size_t)l * (NB * 4 * 256 * 256) + (size_t)(b * 4 + h) * 256 * 256;
    bf16_t* oxa = (bf16_t*)(ws + WS_MIX);
    bf16_t* Kt = (bf16_t*)smem;
    bf16_t* Vt = Kt + 64 * 256;
    constexpr float C2 = 0.0625f * 1.4426950408889634f;
    bf16x8 qa[8];
    {
        const int fsrc = 4 * (4 * lc + lq);
#pragma unroll
        for (int kk = 0; kk < 8; ++kk) {
            const uint4 r = *(const uint4*)(qx + (size_t)(tok0 + (lane >> 2)) * DM + h * 256 + kk * 32 + (lane & 3) * 8);
            const uint4 f = make_uint4((unsigned)__builtin_amdgcn_ds_bpermute(fsrc, (int)r.x), (unsigned)__builtin_amdgcn_ds_bpermute(fsrc, (int)r.y),
                                       (unsigned)__builtin_amdgcn_ds_bpermute(fsrc, (int)r.z), (unsigned)__builtin_amdgcn_ds_bpermute(fsrc, (int)r.w));
            qa[kk] = __builtin_bit_cast(bf16x8, f);
        }
    }
    float ss = 0.f;
#pragma unroll
    for (int kk = 0; kk < 8; ++kk)
#pragma unroll
        for (int e = 0; e < 8; ++e) { const float f = bf2f((bf16_t)qa[kk][e]); ss += f * f; }
    ss += __shfl_xor(ss, 16); ss += __shfl_xor(ss, 32);
    const float kmax = 2.f * sqrtf(__uint_as_float(__hip_atomic_load((const unsigned*)(ws + WS_KNMAX) + l * 4, __ATOMIC_RELAXED, __HIP_MEMORY_SCOPE_AGENT)));
    const float mb2 = sqrtf(ss) * C2 * kmax;
    f32x4 o[16];
#pragma unroll
    for (int nd = 0; nd < 16; ++nd) o[nd] = (f32x4){0.f, 0.f, 0.f, 0.f};
    float lp = 0.f;
    for (int j = 0; j < 4; ++j) {
        __syncthreads();
        {
            const int krow_in = lane >> 5, kpos = lane & 31, vrow_in = lane >> 3, vpos = lane & 7;
#pragma unroll
            for (int i = 0; i < 8; ++i) {
                const int pc = w * 8 + i;
                const int krow = pc * 2 + krow_in;
                glds16(km + (size_t)(j * 64 + krow) * 256 + ((kpos ^ (krow & 15)) << 3), Kt + pc * 512);
                const int vrow = pc * 8 + vrow_in;
                glds16(vmT + (size_t)vrow * 256 + j * 64 + ((vpos ^ vrow_in) << 3), Vt + pc * 512);
            }
        }
        asm volatile("s_waitcnt vmcnt(0)" ::: "memory");
        __syncthreads();
        float pv[4][4];
#pragma unroll
        for (int ni = 0; ni < 4; ++ni) {
            f32x4 s = (f32x4){0.f, 0.f, 0.f, 0.f};
            const int row = ni * 16 + lc;
#pragma unroll
            for (int kk = 0; kk < 8; ++kk) {
                const bf16x8 kb = *(const bf16x8*)(Kt + row * 256 + (((kk * 4 + lq) ^ (row & 15)) << 3));
                s = mfma16(kb, qa[kk], s);
            }
#pragma unroll
            for (int r = 0; r < 4; ++r) { pv[ni][r] = __builtin_amdgcn_exp2f(fmaf(s[r], C2, -mb2)); lp += pv[ni][r]; }
        }
        bf16x8 pb[2];
#pragma unroll
        for (int sx = 0; sx < 2; ++sx) {
            const uint4 pk = make_uint4(pack2(pv[2 * sx][0], pv[2 * sx][1]), pack2(pv[2 * sx][2], pv[2 * sx][3]),
                                        pack2(pv[2 * sx + 1][0], pv[2 * sx + 1][1]), pack2(pv[2 * sx + 1][2], pv[2 * sx + 1][3]));
            pb[sx] = __builtin_bit_cast(bf16x8, pk);
        }
#pragma unroll
        for (int nd = 0; nd < 16; ++nd) {
            const int row = nd * 16 + lc;
#pragma unroll
            for (int sx = 0; sx < 2; ++sx) {
                const int c0 = 4 * sx + (lq >> 1), c1 = c0 + 2;
                const uint2 lo = *(const uint2*)(Vt + row * 64 + ((c0 ^ (lc & 7)) << 3) + (lq & 1) * 4);
                const uint2 hi = *(const uint2*)(Vt + row * 64 + ((c1 ^ (lc & 7)) << 3) + (lq & 1) * 4);
                o[nd] = mfma16(__builtin_bit_cast(bf16x8, make_uint4(lo.x, lo.y, hi.x, hi.y)), pb[sx], o[nd]);
            }
        }
    }
    lp += __shfl_xor(lp, 16); lp += __shfl_xor(lp, 32);
    const float linv = 1.f / lp;
    const int osrc = 4 * (16 * (lane & 3) + (lane >> 2));
#pragma unroll
    for (int nd = 0; nd < 16; ++nd) {
        const unsigned w0 = pack2(o[nd][0] * linv, o[nd][1] * linv), w1 = pack2(o[nd][2] * linv, o[nd][3] * linv);
        *(uint2*)(oxa + (size_t)(tok0 + (lane >> 2)) * DM + h * 256 + nd * 16 + (lane & 3) * 4) =
            make_uint2((unsigned)__builtin_amdgcn_ds_bpermute(osrc, (int)w0), (unsigned)__builtin_amdgcn_ds_bpermute(osrc, (int)w1));
    }
}

__device__ __forceinline__ void peer_hn_rows(const Params& p, int l) {
    const int tid = launder(threadIdx.x), lane = tid & 63, w = tid >> 6;
    char* ws = launder_p(p.ws);
    const bf16_t* xbr = (const bf16_t*)(ws + WS_XB);
    const float* sumsq2 = (const float*)(ws + WS_SUMSQ) + (size_t)(l * 2 + 1) * T_ * 16;
    const float* gf = p.in[22] + l * 1024;
    unsigned char* hnb = (unsigned char*)(ws + WS_HN);
    float4 gg[4];
#pragma unroll
    for (int i = 0; i < 4; ++i) gg[i] = *(const float4*)(gf + lane * 16 + i * 4);
    const int stride = gridDim.x * 4;
    for (int t = blockIdx.x * 4 + w; t < T_; t += stride * 4) {
        uint4 x0[4], x1[4]; float rs[4];
#pragma unroll
        for (int k = 0; k < 4; ++k) {
            const int tk = (t + k * stride < T_) ? t + k * stride : t;
            x0[k] = *(const uint4*)(xbr + (size_t)tk * DM + lane * 16); x1[k] = *(const uint4*)(xbr + (size_t)tk * DM + lane * 16 + 8);
            rs[k] = rstd_from_parts(sumsq2, tk);
        }
#pragma unroll
        for (int k = 0; k < 4; ++k) {
            float hn[16];
            const unsigned xw[8] = {x0[k].x, x0[k].y, x0[k].z, x0[k].w, x1[k].x, x1[k].y, x1[k].z, x1[k].w};
#pragma unroll
            for (int i = 0; i < 4; ++i) {
                hn[i * 4] = __uint_as_float(xw[2 * i] << 16) * rs[k] * gg[i].x; hn[i * 4 + 1] = __uint_as_float(xw[2 * i] & 0xFFFF0000u) * rs[k] * gg[i].y;
                hn[i * 4 + 2] = __uint_as_float(xw[2 * i + 1] << 16) * rs[k] * gg[i].z; hn[i * 4 + 3] = __uint_as_float(xw[2 * i + 1] & 0xFFFF0000u) * rs[k] * gg[i].w;
            }
            int o[4];
#pragma unroll
            for (int i = 0; i < 4; ++i) {
                int wd = 0;
                wd = __builtin_amdgcn_cvt_pk_fp8_f32(hn[4 * i], hn[4 * i + 1], wd, false);
                wd = __builtin_amdgcn_cvt_pk_fp8_f32(hn[4 * i + 2], hn[4 * i + 3], wd, true);
                o[i] = wd;
            }
            if (t + k * stride < T_) *(uint4*)(hnb + (size_t)(t + k * stride) * DM + lane * 16) = make_uint4((unsigned)o[0], (unsigned)o[1], (unsigned)o[2], (unsigned)o[3]);
        }
    }
}

typedef int i32x8_t __attribute__((ext_vector_type(8)));
constexpr int U_TB = 16;
constexpr int U_LISTCAP = U_TB * 128;

__device__ __forceinline__ void peer_u_phase(const Params& p, int l, char* smem) {
    const int tid = launder(threadIdx.x), lane = tid & 63, w = __builtin_amdgcn_readfirstlane(tid >> 6), n16 = lane & 15, kb = lane >> 4;
    char* ws = launder_p(p.ws);
    const unsigned char* u4 = (const unsigned char*)(ws + WS_UB) + (size_t)l * 16384 * 512;
    const unsigned char* hn8 = (const unsigned char*)(ws + WS_HN);
    const unsigned* eid2 = (const unsigned*)(ws + WS_EID);
    const float* gate = (const float*)(ws + WS_GATE);
    float* wgt = (float*)(ws + WS_ACT);
    unsigned* list = (unsigned*)(smem + w * (U_LISTCAP * 8));
    float* glist = (float*)(list + U_LISTCAP);
    const int G8 = (gridDim.x >= 8) ? 8 : 1;
    const int x = blockIdx.x % G8, bidx = blockIdx.x / G8, nbl = (gridDim.x - x + G8 - 1) / G8;
    const int nsl = 8 / G8;
    const int nbatch = T_ / U_TB / 2;
    const int bsrc = 4 * (4 * n16 + kb);
    for (int r = 0; r < nsl; ++r) {
        const unsigned sl = (unsigned)((x * nsl + r) & 3);
        const int bt0 = ((x * nsl + r) >> 2) * nbatch;
        for (int bt = bidx * 4 + w; bt < nbatch; bt += nbl * 4) {
            const int t0 = (bt0 + bt) * U_TB;
            uint4 A[16];
            {
                const unsigned char* hr = hn8 + (size_t)(t0 + (lane >> 2)) * DM + (lane & 3) * 16;
#pragma unroll
                for (int s = 0; s < 8; ++s) { A[2 * s] = *(const uint4*)(hr + s * 128); A[2 * s + 1] = *(const uint4*)(hr + s * 128 + 64); }
#pragma unroll
                for (int s = 0; s < 16; ++s) {
                    A[s].x = (unsigned)__builtin_amdgcn_ds_bpermute(bsrc, (int)A[s].x); A[s].y = (unsigned)__builtin_amdgcn_ds_bpermute(bsrc, (int)A[s].y);
                    A[s].z = (unsigned)__builtin_amdgcn_ds_bpermute(bsrc, (int)A[s].z); A[s].w = (unsigned)__builtin_amdgcn_ds_bpermute(bsrc, (int)A[s].w);
                }
            }
            int n = 0;
#pragma unroll 1
            for (int c = 0; c < U_TB; c += 4) {
                unsigned ids2[4]; float2 gt2[4];
#pragma unroll
                for (int i = 0; i < 4; ++i) { ids2[i] = eid2[(size_t)(t0 + c + i) * 64 + lane]; gt2[i] = *(const float2*)(gate + (size_t)(t0 + c + i) * 128 + 2 * lane); }
#pragma unroll
                for (int i = 0; i < 4; ++i) {
                    const unsigned id0 = ids2[i] & 0xFFFFu, id1 = ids2[i] >> 16;
                    const bool m0 = (id0 >> 12) == sl, m1 = (id1 >> 12) == sl;
                    const unsigned long long b0 = __ballot(m0), b1 = __ballot(m1);
                    const int n0 = __popcll(b0);
                    const int pos0 = n + __builtin_amdgcn_mbcnt_hi((unsigned)(b0 >> 32), __builtin_amdgcn_mbcnt_lo((unsigned)b0, 0u));
                    const int pos1 = n + n0 + __builtin_amdgcn_mbcnt_hi((unsigned)(b1 >> 32), __builtin_amdgcn_mbcnt_lo((unsigned)b1, 0u));
                    if (m0) { list[pos0] = ((unsigned)(c + i) << 24) | ((unsigned)(2 * lane) << 16) | id0; glist[pos0] = gt2[i].x; }
                    if (m1) { list[pos1] = ((unsigned)(c + i) << 24) | ((unsigned)(2 * lane + 1) << 16) | id1; glist[pos1] = gt2[i].y; }
                    n += n0 + __popcll(b1);
                }
            }
            if (n == 0) continue;
            const int ng = (n + 15) >> 4;
  \

#define U_FETCH(UB, EB, GB, g_) do { const int ei_ = (g_) * 16 + n16, ec_ = ei_ < n ? ei_ : 0; EB = list[ec_]; GB = glist[ec_]; \
        const int er_ = (g_) * 16 + (lane >> 2); const unsigned ER_ = list[er_ < n ? er_ : 0]; \
        const unsigned char* ur_ = u4 + (size_t)(ER_ & 0xFFFFu) * 512 + (lane & 3) * 16; \
        _Pragma("unroll") for (int s = 0; s < 8; ++s) UB[s] = *(const uint4*)(ur_ + s * 64); __builtin_amdgcn_sched_barrier(0); } while (0)
#define U_MATH(UB, EB, GB, g_) do { f32x4 acc_ = (f32x4){0.f, 0.f, 0.f, 0.f}; \
        _Pragma("unroll") for (int s = 0; s < 8; ++s) { \
            const i32x8_t av_ = {(int)A[2 * s].x, (int)A[2 * s].y, (int)A[2 * s].z, (int)A[2 * s].w, (int)A[2 * s + 1].x, (int)A[2 * s + 1].y, (int)A[2 * s + 1].z, (int)A[2 * s + 1].w}; \
            const i32x8_t bv_ = {__builtin_amdgcn_ds_bpermute(bsrc, (int)UB[s].x), __builtin_amdgcn_ds_bpermute(bsrc, (int)UB[s].y), \
                                 __builtin_amdgcn_ds_bpermute(bsrc, (int)UB[s].z), __builtin_amdgcn_ds_bpermute(bsrc, (int)UB[s].w), 0, 0, 0, 0}; \
            acc_ = __builtin_amdgcn_mfma_scale_f32_16x16x128_f8f6f4(av_, bv_, acc_, 0, 4, 0, 0, 0, 0); } \
        const int ei_ = (g_) * 16 + n16; const int tk_ = (int)((EB >> 16) & 0xFFu), ti_ = (int)(EB >> 24), rs_ = ti_ & 3; \
        const float d_ = rs_ == 0 ? acc_[0] : (rs_ == 1 ? acc_[1] : (rs_ == 2 ? acc_[2] : acc_[3])); \
        if (ei_ < n && (ti_ >> 2) == kb) glist[ei_] = GB * gelu_tanh(d_ * (1.f / U_SCALE)); } while (0)
            uint4 u0[8], u1[8], u2[8]; unsigned e0 = 0u, e1 = 0u, e2 = 0u; float g0 = 0.f, g1 = 0.f, g2 = 0.f;
            U_FETCH(u0, e0, g0, 0); U_FETCH(u1, e1, g1, 1);
            for (int g = 0; g < ng; g += 3) {
                U_FETCH(u2, e2, g2, g + 2);
                U_MATH(u0, e0, g0, g);
                if (g + 1 >= ng) break;
                U_FETCH(u0, e0, g0, g + 3);
                U_MATH(u1, e1, g1, g + 1);
                if (g + 2 >= ng) break;
                U_FETCH(u1, e1, g1, g + 4);
                U_MATH(u2, e2, g2, g + 2);
            }
#undef U_FETCH
#undef U_MATH
            for (int i = lane; i < n; i += 64) { const unsigned e = list[i]; wgt[(size_t)(t0 + (int)(e >> 24)) * 128 + (int)((e >> 16) & 0xFFu)] = glist[i] * 16.f; }
        }
    }
}

typedef short v4i16_t __attribute__((ext_vector_type(4)));
__device__ __forceinline__ unsigned pack4_fp8(float4 v) {
    int wd = 0;
    wd = __builtin_amdgcn_cvt_pk_fp8_f32(v.x, v.y, wd, false);
    wd = __builtin_amdgcn_cvt_pk_fp8_f32(v.z, v.w, wd, true);
    return (unsigned)wd;
}
constexpr float W_SCALE = 16.f;

__device__ __forceinline__ void peer_v_phase(const Params& p, int l, char* smem) {
    const int tid = launder(threadIdx.x), lane = tid & 63, w = __builtin_amdgcn_readfirstlane(tid >> 6), n16 = lane & 15, kb = lane >> 4;
    char* ws = launder_p(p.ws);
    const unsigned char* v4 = (const unsigned char*)(ws + WS_VB) + (size_t)l * 16384 * 512;
    const unsigned* eid2 = (const unsigned*)(ws + WS_EID);
    const float* wgt = (const float*)(ws + WS_ACT);
    bf16_t* xb = (bf16_t*)(ws + WS_XB);
    float* parts = (float*)(ws + WS_PARTS0);
    char* buf = smem + w * 16384;
    const int G8 = (gridDim.x >= 8) ? 8 : 1;
    const int x = blockIdx.x % G8, bidx = blockIdx.x / G8, nbl = (gridDim.x - x + G8 - 1) / G8;
    const int nsl = 8 / G8;
    const int sh = 8 * (n16 & 3);
    const unsigned rmask = n16 < 4 ? 0xFFFFFFFFu : 0u;
    const int trofs = kb * 1024 + (n16 >> 2) * 128 + 8 * (n16 & 3);
    const unsigned trbase = (unsigned)(size_t)(__attribute__((address_space(3))) char*)(buf) + (unsigned)trofs;
    const int idsrc = 4 * (lane >> 4);
    const bool idhi = ((lane >> 3) & 1) != 0;
    for (int r = 0; r < nsl; ++r) {
        const int xs = x * nsl + r, cs = xs & 3, tend = ((xs >> 2) + 1) * (T_ / 2), step = nbl * 4;
        int t = (xs >> 2) * (T_ / 2) + bidx * 4 + w;
        if (t >= tend) continue;
        const unsigned char* vsl = v4 + cs * 128 + (lane & 7) * 16;
#define V_GATHER(IDW, eb_) do { _Pragma("unroll") for (int i_ = 0; i_ < 4; ++i_) { \
            const unsigned idp_ = (unsigned)__builtin_amdgcn_ds_bpermute(idsrc + 16 * (4 * (eb_) + i_), (int)(IDW)); \
            const unsigned id_ = idhi ? (idp_ >> 16) : (idp_ & 0xFFFFu); \
            glds16(vsl + (size_t)id_ * 512, buf + (4 * (eb_) + i_) * 1024); } } while (0)
        typedef float f32x4v __attribute__((ext_vector_type(4)));
        typedef unsigned u32x2v __attribute__((ext_vector_type(2)));
        const unsigned idw = eid2[(size_t)t * 64 + lane];
        const int t1 = (t + step < tend) ? t + step : t;
        unsigned idnx = eid2[(size_t)t1 * 64 + lane];
        f32x4v W0, W1, W2, W3, W4, W5, W6, W7;
        {
            const float* wp = wgt + (size_t)t * 128 + 4 * kb;
            W0 = *(const f32x4v*)(wp); W1 = *(const f32x4v*)(wp + 16); W2 = *(const f32x4v*)(wp + 32); W3 = *(const f32x4v*)(wp + 48);
            W4 = *(const f32x4v*)(wp + 64); W5 = *(const f32x4v*)(wp + 80); W6 = *(const f32x4v*)(wp + 96); W7 = *(const f32x4v*)(wp + 112);
        }
        u32x2v X0, X1, X2, X3;
        {
            const bf16_t* xp = xb + (size_t)t * DM + cs * 256 + 4 * n16;
            X0 = *(const u32x2v*)(xp); X1 = *(const u32x2v*)(xp + 64); X2 = *(const u32x2v*)(xp + 128); X3 = *(const u32x2v*)(xp + 192);
        }
        V_GATHER(idw, 0); V_GATHER(idw, 1); V_GATHER(idw, 2); V_GATHER(idw, 3);
        asm volatile("s_waitcnt vmcnt(0)" ::: "memory");
        for (; t < tend; t += step) {
            unsigned A[4][8];
            {
                const unsigned xa[8] = {pack4_fp8(make_float4(W0.x, W0.y, W0.z, W0.w)) & rmask, pack4_fp8(make_float4(W1.x, W1.y, W1.z, W1.w)) & rmask,
                                        pack4_fp8(make_float4(W2.x, W2.y, W2.z, W2.w)) & rmask, pack4_fp8(make_float4(W3.x, W3.y, W3.z, W3.w)) & rmask,
                                        pack4_fp8(make_float4(W4.x, W4.y, W4.z, W4.w)) & rmask, pack4_fp8(make_float4(W5.x, W5.y, W5.z, W5.w)) & rmask,
                                        pack4_fp8(make_float4(W6.x, W6.y, W6.z, W6.w)) & rmask, pack4_fp8(make_float4(W7.x, W7.y, W7.z, W7.w)) & rmask};
#pragma unroll
                for (int eb = 0; eb < 4; ++eb)
#pragma unroll
                    for (int d = 0; d < 4; ++d) { A[eb][d] = ((xa[2 * eb] >> (8 * d)) & 0xFFu) << sh; A[eb][4 + d] = ((xa[2 * eb + 1] >> (8 * d)) & 0xFFu) << sh; }
            }
            const unsigned idn = idnx;
            const uint2 xin[4] = {make_uint2(X0.x, X0.y), make_uint2(X1.x, X1.y), make_uint2(X2.x, X2.y), make_uint2(X3.x, X3.y)};
            bf16_t* xr = xb + (size_t)t * DM + cs * 256 + 4 * n16;
            {
                const int tn = (t + step < tend) ? t + step : t, tnn = (tn + step < tend) ? tn + step : tn;
                const unsigned* ipn = eid2 + (size_t)tnn * 64 + lane;
                const float* wp = wgt + (size_t)tn * 128 + 4 * kb;
                const bf16_t* xp = xb + (size_t)tn * DM + cs * 256 + 4 * n16;
                asm volatile("global_load_dword %0, %13, off\n\t"
                             "global_load_dwordx4 %1, %14, off\n\tglobal_load_dwordx4 %2, %14, off offset:64\n\tglobal_load_dwordx4 %3, %14, off offset:128\n\tglobal_load_dwordx4 %4, %14, off offset:192\n\t"
                             "global_load_dwordx4 %5, %14, off offset:256\n\tglobal_load_dwordx4 %6, %14, off offset:320\n\tglobal_load_dwordx4 %7, %14, off offset:384\n\tglobal_load_dwordx4 %8, %14, off offset:448\n\t"
                             "global_load_dwordx2 %9, %15, off\n\tglobal_load_dwordx2 %10, %15, off offset:128\n\tglobal_load_dwordx2 %11, %15, off offset:256\n\tglobal_load_dwordx2 %12, %15, off offset:384"
                             : "=&v"(idnx), "=&v"(W0), "=&v"(W1), "=&v"(W2), "=&v"(W3), "=&v"(W4), "=&v"(W5), "=&v"(W6), "=&v"(W7), "=&v"(X0), "=&v"(X1), "=&v"(X2), "=&v"(X3)
                             : "v"(ipn), "v"(wp), "v"(xp) : "memory");
            }
            f32x4 acc[4];
#pragma unroll
            for (int cb = 0; cb < 4; ++cb) acc[cb] = (f32x4){0.f, 0.f, 0.f, 0.f};
#pragma unroll
            for (int eb = 0; eb < 4; ++eb) {
                asm volatile("s_waitcnt vmcnt(25)" ::: "memory");
                const i32x8_t av = {(int)A[eb][0], (int)A[eb][1], (int)A[eb][2], (int)A[eb][3], (int)A[eb][4], (int)A[eb][5], (int)A[eb][6], (int)A[eb][7]};
                unsigned long long q0, q1, q2, q3, q4, q5, q6, q7;
                const unsigned la = trbase + eb * 4096;
                asm volatile("ds_read_b64_tr_b16 %0, %8\n\tds_read_b64_tr_b16 %1, %8 offset:512\n\t"
                             "ds_read_b64_tr_b16 %2, %8 offset:32\n\tds_read_b64_tr_b16 %3, %8 offset:544\n\t"
                             "ds_read_b64_tr_b16 %4, %8 offset:64\n\tds_read_b64_tr_b16 %5, %8 offset:576\n\t"
                             "ds_read_b64_tr_b16 %6, %8 offset:96\n\tds_read_b64_tr_b16 %7, %8 offset:608\n\t"
                             "s_waitcnt lgkmcnt(0)"
                             : "=&v"(q0), "=&v"(q1), "=&v"(q2), "=&v"(q3), "=&v"(q4), "=&v"(q5), "=&v"(q6), "=&v"(q7) : "v"(la) : "memory");
                {
                    const i32x8_t bv0 = {(int)q0, (int)(q0 >> 32), (int)q1, (int)(q1 >> 32), 0, 0, 0, 0};
                    const i32x8_t bv1 = {(int)q2, (int)(q2 >> 32), (int)q3, (int)(q3 >> 32), 0, 0, 0, 0};
                    const i32x8_t bv2 = {(int)q4, (int)(q4 >> 32), (int)q5, (int)(q5 >> 32), 0, 0, 0, 0};
                    const i32x8_t bv3 = {(int)q6, (int)(q6 >> 32), (int)q7, (int)(q7 >> 32), 0, 0, 0, 0};
                    acc[0] = __builtin_amdgcn_mfma_scale_f32_16x16x128_f8f6f4(av, bv0, acc[0], 0, 4, 0, 0, 0, 0);
                    acc[1] = __builtin_amdgcn_mfma_scale_f32_16x16x128_f8f6f4(av, bv1, acc[1], 0, 4, 0, 0, 0, 0);
                    acc[2] = __builtin_amdgcn_mfma_scale_f32_16x16x128_f8f6f4(av, bv2, acc[2], 0, 4, 0, 0, 0, 0);
                    acc[3] = __builtin_amdgcn_mfma_scale_f32_16x16x128_f8f6f4(av, bv3, acc[3], 0, 4, 0, 0, 0, 0);
                }
                V_GATHER(idn, eb);
                __builtin_amdgcn_sched_barrier(0);
            }
#pragma unroll
            for (int cb = 0; cb < 4; ++cb) {
                constexpr float OS = 1.f / (W_SCALE * V_SCALE);
                const float xv0 = __uint_as_float(xin[cb].x << 16) + acc[cb][0] * OS, xv1 = __uint_as_float(xin[cb].x & 0xFFFF0000u) + acc[cb][1] * OS;
                const float xv2 = __uint_as_float(xin[cb].y << 16) + acc[cb][2] * OS, xv3 = __uint_as_float(xin[cb].y & 0xFFFF0000u) + acc[cb][3] * OS;
                const float ss = row16_sum(xv0 * xv0 + xv1 * xv1 + xv2 * xv2 + xv3 * xv3);
                if (kb == 0) { const unsigned long long pk_ = ((unsigned long long)pack2(xv2, xv3) << 32) | pack2(xv0, xv1);
                    asm volatile("global_store_dwordx2 %0, %1, off sc1" :: "v"(xr + cb * 64), "v"(pk_) : "memory"); }
                if (lane == 0) asm volatile("global_store_dword %0, %1, off sc1" :: "v"(parts + (size_t)t * 16 + cs * 4 + cb), "v"(ss) : "memory");
            }
            asm volatile("s_waitcnt vmcnt(16)" : "+v"(W0), "+v"(W1), "+v"(W2), "+v"(W3), "+v"(W4), "+v"(W5), "+v"(W6), "+v"(W7), "+v"(idnx), "+v"(X0), "+v"(X1), "+v"(X2), "+v"(X3) :: "memory");
        }
#undef V_GATHER
        asm volatile("s_waitcnt vmcnt(0)" ::: "memory");
    }
}

__device__ __forceinline__ void final_norm_phase(const Params& p) {
    const int tid = launder(threadIdx.x), lane = tid & 63, w = tid >> 6;
    char* ws = launder_p(p.ws);
    const bf16_t* xbr = (const bf16_t*)(ws + WS_XB);
    const float* parts = (const float*)(ws + WS_PARTS0);
    const float* fg = p.in[27];
    float4 g[2][2];
#pragma unroll
    for (int i = 0; i < 2; ++i) { g[i][0] = *(const float4*)(fg + i * 512 + lane * 8); g[i][1] = *(const float4*)(fg + i * 512 + lane * 8 + 4); }
    const int stride = gridDim.x * 4;
    for (int t = blockIdx.x * 4 + w; t < T_; t += stride * 4) {
        uint4 a[4][2]; float rn[4];
#pragma unroll
        for (int k = 0; k < 4; ++k) {
            const int tk = (t + k * stride < T_) ? t + k * stride : t;
            a[k][0] = *(const uint4*)(xbr + (size_t)tk * DM + lane * 8); a[k][1] = *(const uint4*)(xbr + (size_t)tk * DM + 512 + lane * 8);
            rn[k] = rstd_from_parts(parts, tk);
        }
#pragma unroll
        for (int k = 0; k < 4; ++k) {
            if (t + k * stride < T_) {
#pragma unroll
                for (int i = 0; i < 2; ++i) {
                    const uint4 v = a[k][i]; const float r = rn[k];
                    float* o = p.out + (size_t)(t + k * stride) * DM + i * 512 + lane * 8;
                    *(float4*)o = make_float4(__uint_as_float(v.x << 16) * r * g[i][0].x, __uint_as_float(v.x & 0xFFFF0000u) * r * g[i][0].y, __uint_as_float(v.y << 16) * r * g[i][0].z, __uint_as_float(v.y & 0xFFFF0000u) * r * g[i][0].w);
                    *(float4*)(o + 4) = make_float4(__uint_as_float(v.z << 16) * r * g[i][1].x, __uint_as_float(v.z & 0xFFFF0000u) * r * g[i][1].y, __uint_as_float(v.w << 16) * r * g[i][1].z, __uint_as_float(v.w & 0xFFFF0000u) * r * g[i][1].w);
                }
            }
        }
    }
}

#define XB_TMO      128
#define XB_XCNT(j)  (256  + 64 * (j))
#define XB_XSUB(j)  (1280 + 64 * (j))
#define XB_XGEN(j)  (2304 + 64 * (j))
#define XB_TOP      3328
#define XB_TOPGEN   3392
#define XCD_BAR_WORDS 3456
#define XB_SPIN_CAP (1u << 22)
#define LAS __attribute__((address_space(3)))
__device__ __forceinline__ unsigned xb_ld(unsigned* p)              { return __hip_atomic_load(p, __ATOMIC_RELAXED, __HIP_MEMORY_SCOPE_AGENT); }
__device__ __forceinline__ unsigned xb_add(unsigned* p, unsigned v) { return __hip_atomic_fetch_add(p, v, __ATOMIC_RELAXED, __HIP_MEMORY_SCOPE_AGENT); }
__device__ __forceinline__ unsigned xb_xcc_id() { return (unsigned)__builtin_amdgcn_s_getreg((3 << 11) | 20) & 0xFu; }
#define XB_SPIN(cond, bar) do { unsigned _sp = 0; while (cond) { __builtin_amdgcn_s_sleep(1); \
    if ((++_sp & 255u) == 0u) { if (xb_ld(&(bar)[XB_TMO])) break; if (_sp > XB_SPIN_CAP) { atomicAdd(&(bar)[XB_TMO], 1u); break; } } } } while (0)
struct XcdBarrier { unsigned* bar; unsigned x; volatile LAS unsigned* st; };
__device__ __forceinline__ XcdBarrier xcd_barrier_post(unsigned* bar, volatile LAS unsigned* st) {
    XcdBarrier b; b.bar = bar; b.x = xb_xcc_id(); b.st = st;
    if (threadIdx.x == 0) (void)xb_add(&bar[XB_XCNT(b.x)], 1u);
    return b;
}
__device__ __forceinline__ void xcd_barrier_complete(unsigned* bar, unsigned x, unsigned& nloc, unsigned& nx) {
    const unsigned G = gridDim.x * gridDim.y * gridDim.z;
    unsigned sum, cnt, mine, sp = 0u;
    for (;;) {
        sum = 0u; cnt = 0u; mine = 0u;
#pragma unroll
        for (unsigned j = 0; j < 16; ++j) { const unsigned c = xb_ld(&bar[XB_XCNT(j)]); sum += c; cnt += (c > 0u) ? 1u : 0u; mine = (j == x) ? c : mine; }
        if (sum == G) break;
        __builtin_amdgcn_s_sleep(1);
        if ((++sp & 255u) == 0u) { if (xb_ld(&bar[XB_TMO])) break; if (sp > XB_SPIN_CAP) { atomicAdd(&bar[XB_TMO], 1u); break; } }
    }
    nloc = mine > 0u ? mine : 1u; nx = cnt > 0u ? cnt : 1u;
}
__device__ __forceinline__ void xcd_barrier(const XcdBarrier& b) {
    asm volatile("s_waitcnt vmcnt(0)" ::: "memory");
    __syncthreads();
    if (threadIdx.x == 0) {
        unsigned* bar = b.bar;
        __builtin_amdgcn_s_waitcnt(0);
        unsigned nloc = b.st[0], nx = b.st[1];
        if (nloc == 0u) { xcd_barrier_complete(bar, b.x, nloc, nx); b.st[0] = nloc; b.st[1] = nx; }
        const unsigned old = xb_add(&bar[XB_XSUB(b.x)], 1u);
        const unsigned gen = old / nloc;
        if (old + 1u == (gen + 1u) * nloc) {
            __builtin_amdgcn_fence(__ATOMIC_RELEASE, "agent");
            asm volatile("s_waitcnt vmcnt(0)" ::: "memory");
            const unsigned og = xb_add(&bar[XB_TOP], 1u);
            const unsigned tg = og / nx;
            if (og + 1u == (tg + 1u) * nx) xb_add(&bar[XB_TOPGEN], 1u);
            else XB_SPIN(xb_ld(&bar[XB_TOPGEN]) == tg, bar);
            __builtin_amdgcn_fence(__ATOMIC_ACQUIRE, "agent");
            asm volatile("s_waitcnt vmcnt(0)" ::: "memory");
        } else {
            XB_SPIN(xb_ld(&bar[XB_TOPGEN]) == gen, bar);
            __builtin_amdgcn_fence(__ATOMIC_ACQUIRE, "agent");
            asm volatile("s_waitcnt vmcnt(0)" ::: "memory");
        }
    }
    __syncthreads();
}


__device__ __forceinline__ bool xcd_tile(int i, int bid, int G, int nM, int nN, int& tm, int& tn) {
    if ((G & 7) != 0 || (nM & 7) != 0) { const int it = bid + i * G; if (it >= nM * nN) return false; tm = it / nN; tn = it % nN; return true; }
    const int x = bid & 7, lt = (bid >> 3) + i * (G >> 3), pm = nM >> 3;
    if (lt >= pm * nN) return false;
    tm = x * pm + lt / nN; tn = lt % nN; return true;
}

constexpr int PH_PER_LAYER = 11;
constexpr int N_PHASES = 1 + 2 * PH_PER_LAYER + 1;

__device__ __forceinline__ void run_phase(const Params& p, int ph, char* smem) {
    char* ws = launder_p(p.ws);
    const int G = gridDim.x, bid = blockIdx.x;
    if (ph == 0) { phase_prep(p, smem); return; }
    if (ph == N_PHASES - 1) { final_norm_phase(p); return; }
    const int l = (ph - 1) / PH_PER_LAYER, sp = (ph - 1) % PH_PER_LAYER;
    char* W = ws + WS_W + l * W_STRIDE;
    float* sumsq1 = (float*)(ws + WS_SUMSQ) + (size_t)(l * 2 + 0) * T_ * 16;
    float* sumsq2 = (float*)(ws + WS_SUMSQ) + (size_t)(l * 2 + 1) * T_ * 16;
    switch (sp) {
    case 0: {
        EpiWin e{(const float*)(ws + WS_PARTS0), (const float*)(ws + WS_ROPE), (bf16_t*)(ws + WS_Q), (bf16_t*)(ws + WS_KC), (bf16_t*)(ws + WS_VC), (bf16_t*)(ws + WS_KS),
                 (bf16_t*)(ws + WS_KW), (bf16_t*)(ws + WS_VST), (bf16_t*)(ws + WS_VWT), (bf16_t*)(ws + WS_GLU), (bf16_t*)(ws + WS_ZP), (float*)(ws + WS_GATES), (unsigned*)(ws + WS_KNMAX) + l * 4};
        ALin al{(const bf16_t*)(ws + WS_XB), DM};
        if (bid == G - 1) {
            const int t_ = launder(threadIdx.x);
            for (int o = t_; o < 512; o += NTHREADS) {
                const float* pp = (const float*)(ws + WS_CBPART) + (size_t)(l * 2 + (o >> 8)) * 32 * 256 + (o & 255);
                float s = 0.f;
                for (int c = 0; c < 32; ++c) s += pp[c * 256];
                ((float*)(W + W_CBIAS))[o] = s;
            }
        }
        const int extra = (l == 0) ? 2 * 8 * 16 : 0;
        { int tm, tn;
          for (int i = 0; xcd_tile(i, bid, G, 128, 17, tm, tn); ++i) {
                if (tn == 7 || tn == 9) gemm_tile<false>(al, (const bf16_t*)(W + W_WIN), DM, NWIN, DM, tm * 128, tn * 128, e, smem);
                else gemm_tile<true>(al, (const bf16_t*)(W + W_WIN), DM, NWIN, DM, tm * 128, tn * 128, e, smem);
          } }
        if (l == 0) conv_weights(p, 0, 4, smem);
        for (int it = bid; it < extra; it += G) {
            {
                const int j = it, ll = j >> 7, r = j & 127, tn = r & 15, tm = r >> 4;
                ALin am{(const bf16_t*)(ws + WS_MEMB), DM};
                EpiMemKV em{(const float*)(ws + WS_RSTDM), (bf16_t*)(ws + WS_KMEM) + (size_t)ll * (NB * 4 * 256 * 256), (bf16_t*)(ws + WS_VMEMT) + (size_t)ll * (NB * 4 * 256 * 256), (unsigned*)(ws + WS_KNMAX) + ll * 4};
                if (tn >= 8) gemm_tile<false>(am, (const bf16_t*)(ws + WS_W + ll * W_STRIDE + W_XWKV), DM, 2048, DM, tm * 128, tn * 128, em, smem);
                else gemm_tile<true>(am, (const bf16_t*)(ws + WS_W + ll * W_STRIDE + W_XWKV), DM, 2048, DM, tm * 128, tn * 128, em, smem);
            }
        }
    } break;
    case 1: {
        const int ncmp = 2 * 16 * 2 * 4;
        for (int it = bid; it < ncmp + 1024; it += G) {
            if (it < ncmp) {
                const int ks = it & 3, r0 = it >> 2, kv = r0 >> 5, r = r0 & 31, tn = r & 1, tm = r >> 1;
                ACmp ac{(const bf16_t*)(ws + (kv == 0 ? WS_KC : WS_VC)), ks * 512};
                EpiCmp1 e{(float*)(ws + WS_CPART) + ((size_t)(ks * 2 + kv)) * 2048 * 256};
                gemm_tile<true>(ac, (const bf16_t*)(W + W_CW1) + (size_t)kv * 256 * 2048 + ks * 512, 2048, 256, 512, tm * 128, tn * 128, e, smem);
            } else {
                convpool_tile(p, l, it - ncmp, smem);
            }
        }
    } break;
    case 2: {
        for (int it = bid; it < 32; it += G) {
            const int kv = it >> 4, tm = it & 15;
            {
                const int t_ = launder(threadIdx.x);
                const float* cpart = (const float*)(ws + WS_CPART);
                const float* bias = (const float*)(W + W_CBIAS) + kv * 256;
                bf16_t* hid = (bf16_t*)(ws + WS_HID) + (size_t)kv * 2048 * 256;
                for (int u = t_; u < 128 * 32; u += NTHREADS) {
                    const int row = tm * 128 + (u >> 5), c0 = (u & 31) * 8;
                    float v[8];
                    { const float4 b0 = *(const float4*)(bias + c0), b1 = *(const float4*)(bias + c0 + 4); v[0] = b0.x; v[1] = b0.y; v[2] = b0.z; v[3] = b0.w; v[4] = b1.x; v[5] = b1.y; v[6] = b1.z; v[7] = b1.w; }
#pragma unroll
                    for (int ks = 0; ks < 4; ++ks) {
                        const float* s = cpart + ((size_t)(ks * 2 + kv) * 2048 + row) * 256 + c0;
                        const float4 a0 = *(const float4*)s, a1 = *(const float4*)(s + 4);
                        v[0] += a0.x; v[1] += a0.y; v[2] += a0.z; v[3] += a0.w; v[4] += a1.x; v[5] += a1.y; v[6] += a1.z; v[7] += a1.w;
                    }
#pragma unroll
                    for (int e = 0; e < 8; ++e) v[e] = gelu_tanh(v[e]);
                    *(uint4*)(hid + (size_t)row * 256 + c0) = pack8(v);
                }
                asm volatile("s_waitcnt vmcnt(0)" ::: "memory");
                __threadfence();
                __syncthreads();
            }
            ALin al{(const bf16_t*)(ws + WS_HID) + (size_t)kv * 2048 * 256, 256};
            EpiCmp2 e{kv, (bf16_t*)(ws + WS_KCMP), (bf16_t*)(ws + WS_VCMPT), (unsigned*)(ws + WS_KNMAX) + l * 4};
            if (kv == 0) gemm_tile<true>(al, (const bf16_t*)(W + W_CW2) + (size_t)kv * 64 * 256, 256, 64, 256, tm * 128, 0, e, smem);
            else gemm_tile<false>(al, (const bf16_t*)(W + W_CW2) + (size_t)kv * 64 * 256, 256, 64, 256, tm * 128, 0, e, smem);
        }
    } break;
    case 3: {
        const int cgt = bid * NTHREADS + launder(threadIdx.x), cgs = G * NTHREADS;
        if (bid & 1) {
            conv_fp4<false>(p.in[25] + (size_t)l * 16384 * 1024, (unsigned char*)(ws + WS_UB) + (size_t)l * 16384 * 512, (size_t)16384 * 1024, U_SCALE, cgt, cgs);
            conv_fp4<false>(p.in[26] + (size_t)l * 16384 * 1024, (unsigned char*)(ws + WS_VB) + (size_t)l * 16384 * 512, (size_t)16384 * 1024, V_SCALE, cgt, cgs);
        }
        if ((G & 7) == 0) {
            unsigned* qctr = (unsigned*)(ws + WS_CTL + 16384) + (l * 8 + (bid & 7)) * 16;
            volatile LAS unsigned* tk = (volatile LAS unsigned*)(smem + 61440);
            bool first = true;
            for (;;) {
                __syncthreads();
                if (threadIdx.x == 0) tk[0] = __hip_atomic_fetch_add(qctr, 1u, __ATOMIC_RELAXED, __HIP_MEMORY_SCOPE_AGENT);
                __syncthreads();
                const unsigned k = tk[0];
                if (k < 128u) nsa_item(p, l, (int)(8u * k) + (bid & 7), smem);
                if (first) {
                    first = false;
                    if (l == 0) conv_weights(p, 1, 1 | 4 | 8, smem);
                    if (!(bid & 1)) {
                        conv_fp4<false>(p.in[25] + (size_t)l * 16384 * 1024, (unsigned char*)(ws + WS_UB) + (size_t)l * 16384 * 512, (size_t)16384 * 1024, U_SCALE, cgt, cgs);
                        conv_fp4<false>(p.in[26] + (size_t)l * 16384 * 1024, (unsigned char*)(ws + WS_VB) + (size_t)l * 16384 * 512, (size_t)16384 * 1024, V_SCALE, cgt, cgs);
                    }
                }
                if (k >= 128u) break;
            }
        } else {
            for (int r = 0; r * G < 1024; ++r) { const int it = (r & 1) ? (r + 1) * G - 1 - bid : r * G + bid; if (it < 1024) nsa_item(p, l, it, smem); }
            if (l == 0) conv_weights(p, 1, 1 | 4 | 8, smem);
            if (!(bid & 1)) {
                conv_fp4<false>(p.in[25] + (size_t)l * 16384 * 1024, (unsigned char*)(ws + WS_UB) + (size_t)l * 16384 * 512, (size_t)16384 * 1024, U_SCALE, cgt, cgs);
                conv_fp4<false>(p.in[26] + (size_t)l * 16384 * 1024, (unsigned char*)(ws + WS_VB) + (size_t)l * 16384 * 512, (size_t)16384 * 1024, V_SCALE, cgt, cgs);
            }
        }
    } break;
    case 4: {
        EpiRes e{(bf16_t*)(ws + WS_XB), sumsq1};
        ALin al{(const bf16_t*)(ws + WS_MIX), DM};
        { int tm, tn, ntm, ntn; bool have = xcd_tile(0, bid, G, 128, 8, tm, tn); int pre = 0;
          for (int i = 0; have; ++i) {
              const bool nxt = xcd_tile(i + 1, bid, G, 128, 8, ntm, ntn);
              gemm_tile<true>(al, (const bf16_t*)(W + W_WOUT), DM, DM, DM, tm * 128, tn * 128, e, smem, pre | (nxt ? 2 : 0), ntm * 128, ntn * 128);
              pre = nxt ? 1 : 0; have = nxt; tm = ntm; tn = ntn;
          } }
    } break;
    case 5: {
        EpiScale e{sumsq1, (bf16_t*)(ws + WS_QXA), DM};
        ALin al{(const bf16_t*)(ws + WS_XB), DM};
        { int tm, tn, ntm, ntn; bool have = xcd_tile(0, bid, G, 128, 8, tm, tn); int pre = 0;
          for (int i = 0; have; ++i) {
              const bool nxt = xcd_tile(i + 1, bid, G, 128, 8, ntm, ntn);
              gemm_tile<true>(al, (const bf16_t*)(W + W_XWQ), DM, DM, DM, tm * 128, tn * 128, e, smem, pre | (nxt ? 2 : 0), ntm * 128, ntn * 128);
              pre = nxt ? 1 : 0; have = nxt; tm = ntm; tn = ntn;
          } }
    } break;
    case 6: {
        for (int it = bid; it < 1024; it += G) xattn_item(p, l, it, smem);
    } break;
    case 7: {
        EpiRes e{(bf16_t*)(ws + WS_XB), sumsq2};
        ALin al{(const bf16_t*)(ws + WS_MIX), DM};
        { int tm, tn, ntm, ntn; bool have = xcd_tile(0, bid, G, 128, 8, tm, tn); int pre = 0;
          for (int i = 0; have; ++i) {
              const bool nxt = xcd_tile(i + 1, bid, G, 128, 8, ntm, ntn);
              gemm_tile<true>(al, (const bf16_t*)(W + W_XWO), DM, DM, DM, tm * 128, tn * 128, e, smem, pre | (nxt ? 2 : 0), ntm * 128, ntn * 128);
              pre = nxt ? 1 : 0; have = nxt; tm = ntm; tn = ntn;
          } }
    } break;
    case 8: {
        EpiPeerQ e{sumsq2, (const bf16_t*)(W + W_SUBK), (unsigned short*)(ws + WS_EID), (float*)(ws + WS_GATE), smem};
        ALin al{(const bf16_t*)(ws + WS_XB), DM};
        { int tm, hh; for (int i = 0; xcd_tile(i, bid, G, 128, 8, tm, hh); ++i) {
            gemm_tile<true>(al, (const bf16_t*)(W + W_PWQ), DM, 2048, DM, tm * 128, (2 * hh) * 128, e, smem);
            gemm_tile<true>(al, (const bf16_t*)(W + W_PWQ), DM, 2048, DM, tm * 128, (2 * hh + 1) * 128, e, smem); } }
        peer_hn_rows(p, l);
    } break;
    case 9: peer_u_phase(p, l, smem); break;
    case 10: peer_v_phase(p, l, smem); break;
    }
}

__global__ void __launch_bounds__(NTHREADS, 2) mega_kernel(Params p) {
    extern __shared__ __attribute__((aligned(16))) char smem[];
    volatile LAS unsigned* bst = (volatile LAS unsigned*)(smem + LDS_PHASE_BYTES);
    XcdBarrier xb; xb.bar = (unsigned*)(p.ws + WS_CTL); xb.x = 0; xb.st = bst;
    if (p.ph_hi - p.ph_lo > 1) {
        if (threadIdx.x < 4) bst[threadIdx.x] = 0u;
        __syncthreads();
    }
    for (int ph = p.ph_lo; ph < p.ph_hi; ++ph) {
        run_phase(p, ph, smem);
        if (ph + 1 < p.ph_hi) {
            if (ph == p.ph_lo) {
                cg::this_grid().sync();
                xb = xcd_barrier_post((unsigned*)(p.ws + WS_CTL), bst);
            } else xcd_barrier(xb);
        }
    }
}

extern "C" void kernel_launch(void* const* d_in, const int* in_sizes, int n_in, void* d_out, int out_size, void* d_ws, size_t ws_size, hipStream_t stream) {
    static int grid = 0;
    if (grid == 0) {
        if (n_in != 28 || ws_size < WS_END) { fprintf(stderr, "kernel_launch: unexpected inputs (%d) or workspace (%zu < %zu)\n", n_in, ws_size, (size_t)WS_END); grid = -1; return; }
        int dev = 0, cus = 0, per_cu = 0;
        hipGetDevice(&dev);
        hipDeviceGetAttribute(&cus, hipDeviceAttributeMultiprocessorCount, dev);
        hipFuncSetAttribute((const void*)mega_kernel, hipFuncAttributeMaxDynamicSharedMemorySize, LDS_BYTES);
        hipOccupancyMaxActiveBlocksPerMultiprocessor(&per_cu, (const void*)mega_kernel, NTHREADS, LDS_BYTES);
        if (per_cu < 1) { fprintf(stderr, "kernel_launch: occupancy query returned %d\n", per_cu); grid = -1; return; }
        if (per_cu > 2) per_cu = 2;
        grid = cus * per_cu;
    }
    if (grid < 0) return;
    Params p{};
    for (int i = 0; i < 28; ++i) p.in[i] = (const float*)d_in[i];
    p.out = (float*)d_out; p.ws = (char*)d_ws;
    for (int i = 0; i < 8; ++i) p.freq[i] = pow(500000.0, -(double)i / 8.0);
#if SINGLE_LAUNCH
    p.ph_lo = 0; p.ph_hi = N_PHASES;
    void* args[] = {&p};
    hipError_t e = hipLaunchCooperativeKernel((const void*)mega_kernel, dim3(grid), dim3(NTHREADS), args, LDS_BYTES, stream);
    if (e != hipSuccess) fprintf(stderr, "cooperative launch failed: %s (grid %d)\n", hipGetErrorString(e), grid);
#else
    for (int ph = 0; ph < N_PHASES; ++ph) {
        p.ph_lo = ph; p.ph_hi = ph + 1;
        hipLaunchKernelGGL(mega_kernel, dim3(grid), dim3(NTHREADS), LDS_BYTES, stream, p);
#ifdef REPEAT_LIST
        { const int rl[] = {REPEAT_LIST}; for (int r : rl) if (r == ph) hipLaunchKernelGGL(mega_kernel, dim3(grid), dim3(NTHREADS), LDS_BYTES, stream, p); }
#endif
    }
#endif
}

#ifdef PHASE_PROBE
template <int PH> __global__ void __launch_bounds__(NTHREADS, 2) probe_kernel(Params p) {
    extern __shared__ __attribute__((aligned(16))) char smem[];
    run_phase(p, PH, smem);
}
#ifdef ONLY_PH
template __global__ void probe_kernel<ONLY_PH>(Params);
#else
template __global__ void probe_kernel<0>(Params);
template __global__ void probe_kernel<1>(Params);
template __global__ void probe_kernel<2>(Params);
template __global__ void probe_kernel<3>(Params);
template __global__ void probe_kernel<4>(Params);
template __global__ void probe_kernel<5>(Params);
template __global__ void probe_kernel<6>(Params);
template __global__ void probe_kernel<7>(Params);
template __global__ void probe_kernel<8>(Params);
template __global__ void probe_kernel<9>(Params);
template __global__ void probe_kernel<10>(Params);
template __global__ void probe_kernel<11>(Params);
#endif
#endif
```
